# Optimizing an MI355X kernel written in HIP

```python
import math
import jax, jax.numpy as jnp
from jax import lax
import numpy as np


D_MODEL = 2048
BATCH = 2
SEQ = 8192
DEPTH = 2

N_HEADS = 8
HEAD_DIM = 64
ATTN_WIDTH = N_HEADS * 2 * HEAD_DIM
POOL_WINDOWS = (2, 4, 8, 16)
POOL_GROUP = 256
POOL_WIDTH = POOL_GROUP * len(POOL_WINDOWS)
MAX_WINDOW = max(POOL_WINDOWS)
N_BUCKETS = 32
MAX_DISTANCE = 128
BLOCK_Q = 128
D_FF_DENSE = 5632
N_EXPERTS = 8
TOP_K = 2
D_FF_EXPERT = 7168
ALPHA = (2.0 * DEPTH) ** 0.25
BETA = (8.0 * DEPTH) ** -0.25
LN_EPS = 1e-5
N_DENSE = (DEPTH + 1) // 2
N_MOE = DEPTH // 2
IN_COLS = (ATTN_WIDTH, ATTN_WIDTH, ATTN_WIDTH, POOL_WIDTH, D_MODEL, D_MODEL)
IN_WIDTH = sum(IN_COLS)
SPLIT_POINTS = tuple(int(s) for s in np.cumsum(IN_COLS)[:-1])

kernel_name = 'hybrid_diffattn_pool_moe_block'


def layer_norm(x, g, b):
    xf = x.astype(jnp.float32)
    mu = jnp.mean(xf, axis=-1, keepdims=True)
    var = jnp.mean(jnp.square(xf - mu), axis=-1, keepdims=True)
    return ((xf - mu) * lax.rsqrt(var + LN_EPS) * g.astype(jnp.float32) + b.astype(jnp.float32)).astype(x.dtype)


def t5_causal_bucket(q_pos, k_pos):
    n = jnp.maximum(q_pos[:, None] - k_pos[None, :], 0)
    max_exact = N_BUCKETS // 2
    large = max_exact + (jnp.log(jnp.maximum(n, 1).astype(jnp.float32) / max_exact)
                         / math.log(MAX_DISTANCE / max_exact) * (N_BUCKETS - max_exact)).astype(jnp.int32)
    large = jnp.minimum(large, N_BUCKETS - 1)
    return jnp.where(n < max_exact, n, large)


def diff_attention(q, k, v, rel_bias, lam):
    B, S = q.shape[0], q.shape[1]
    k_pos = jnp.arange(S)
    scale = HEAD_DIM ** -0.5

    def block(i):
        start = i * BLOCK_Q
        qb = lax.dynamic_slice_in_dim(q, start, BLOCK_Q, axis=1)
        q_pos = start + jnp.arange(BLOCK_Q)
        s = jnp.einsum('bqhcd,bkhcd->bchqk', qb, k).astype(jnp.float32) * scale
        bias = jnp.transpose(rel_bias[t5_causal_bucket(q_pos, k_pos)].astype(jnp.float32), (2, 0, 1))
        causal = k_pos[None, :] <= q_pos[:, None]
        s = jnp.where(causal, s + bias, -jnp.inf)
        p = jax.nn.softmax(s, axis=-1)
        a = p[:, 0] - lam * p[:, 1]
        return jnp.einsum('bhqk,bkhe->bqhe', a.astype(v.dtype), v)

    o = lax.map(block, jnp.arange(S // BLOCK_Q))
    return jnp.moveaxis(o, 0, 1).reshape(B, S, N_HEADS, 2 * HEAD_DIM)


def multiscale_pool(u, pool_w, pool_scale):
    B, S, _ = u.shape
    ug = u.astype(jnp.float32).reshape(B, S, len(POOL_WINDOWS), POOL_GROUP)
    c = jnp.cumsum(ug, axis=1)
    c = jnp.concatenate([jnp.zeros((B, MAX_WINDOW) + c.shape[2:], jnp.float32), c], axis=1)
    t = jnp.arange(S)
    means = []
    for g, w in enumerate(POOL_WINDOWS):
        win_sum = c[:, MAX_WINDOW:, g] - c[:, MAX_WINDOW - w:MAX_WINDOW - w + S, g]
        cnt = jnp.minimum(t + 1, w).astype(jnp.float32)
        means.append(win_sum / cnt[None, :, None])
    z = (jnp.stack(means, axis=2) - ug).astype(u.dtype)
    y = jnp.einsum('bsgc,gce->bsge', z, pool_w).reshape(B, S, POOL_WIDTH)
    return y * pool_scale


def hybrid_mixer(h, w_in, lam_vec, subln_w, pool_w, pool_scale, w_ba, w_bp, w_out, rel_bias, lambda_init):
    B, S, _ = h.shape
    proj = h @ w_in
    q, k, v, u, ga, gp = jnp.split(proj, SPLIT_POINTS, axis=-1)
    q = q.reshape(B, S, N_HEADS, 2, HEAD_DIM)
    k = k.reshape(B, S, N_HEADS, 2, HEAD_DIM)
    v = v.reshape(B, S, N_HEADS, 2 * HEAD_DIM)
    lv = lam_vec.astype(jnp.float32)
    lam = jnp.exp(jnp.sum(lv[0] * lv[1])) - jnp.exp(jnp.sum(lv[2] * lv[3])) + lambda_init
    o = diff_attention(q, k, v, rel_bias, lam).astype(jnp.float32)
    o = o * lax.rsqrt(jnp.mean(jnp.square(o), axis=-1, keepdims=True) + LN_EPS) * subln_w.astype(jnp.float32) * (1.0 - lambda_init)
    attn_out = o.reshape(B, S, ATTN_WIDTH).astype(h.dtype)
    pool_out = multiscale_pool(u, pool_w, pool_scale)
    merged = jax.nn.sigmoid(ga) * (attn_out @ w_ba) + jax.nn.sigmoid(gp) * (pool_out @ w_bp)
    return merged @ w_out


def dense_swiglu(h, wg, wu, wd):
    return (jax.nn.silu(h @ wg) * (h @ wu)) @ wd


def moe_swiglu(h, router_w, wg, wu, wd):
    B, S, D = h.shape
    t = h.reshape(B * S, D)
    logits = (t @ router_w).astype(jnp.float32)
    top_v, top_i = lax.top_k(logits, TOP_K)
    top_w = jax.nn.softmax(top_v, axis=-1)
    gates = jnp.sum(jax.nn.one_hot(top_i, N_EXPERTS, dtype=jnp.float32) * top_w[..., None], axis=1)
    y = jnp.zeros((B * S, D), jnp.float32)
    for e in range(N_EXPERTS):
        he = jax.nn.silu(t @ wg[e]) * (t @ wu[e])
        y = y + gates[:, e:e + 1] * (he @ wd[e]).astype(jnp.float32)
    return y.reshape(B, S, D).astype(h.dtype)


def setup_inputs(seed: int = 0) -> dict:
    key = jax.random.key(seed)
    ks = jax.random.split(key, 24)

    def nrm(k, shape, s):
        return jax.random.normal(k, shape, jnp.float32) * s

    return {
        'x': nrm(ks[0], (BATCH, SEQ, D_MODEL), 1.0),
        'w_in': nrm(ks[1], (DEPTH, D_MODEL, IN_WIDTH), D_MODEL ** -0.5),
        'lambdas': nrm(ks[2], (DEPTH, 4, HEAD_DIM), 0.1),
        'subln_w': 1.0 + nrm(ks[3], (DEPTH, 2 * HEAD_DIM), 0.02),
        'pool_w': nrm(ks[4], (DEPTH, len(POOL_WINDOWS), POOL_GROUP, POOL_GROUP), POOL_GROUP ** -0.5),
        'pool_scale': 1.0 + nrm(ks[5], (DEPTH, POOL_WIDTH), 0.02),
        'w_branch_attn': nrm(ks[6], (DEPTH, ATTN_WIDTH, D_MODEL), ATTN_WIDTH ** -0.5),
        'w_branch_pool': nrm(ks[7], (DEPTH, POOL_WIDTH, D_MODEL), POOL_WIDTH ** -0.5),
        'w_out': nrm(ks[8], (DEPTH, D_MODEL, D_MODEL), BETA * D_MODEL ** -0.5),
        'rel_bias': nrm(ks[9], (N_BUCKETS, N_HEADS), 0.5),
        'ln1_g': 1.0 + nrm(ks[10], (DEPTH, D_MODEL), 0.02),
        'ln1_b': nrm(ks[11], (DEPTH, D_MODEL), 0.02),
        'dense_w_gate': nrm(ks[12], (N_DENSE, D_MODEL, D_FF_DENSE), D_MODEL ** -0.5),
        'dense_w_up': nrm(ks[13], (N_DENSE, D_MODEL, D_FF_DENSE), D_MODEL ** -0.5),
        'dense_w_down': nrm(ks[14], (N_DENSE, D_FF_DENSE, D_MODEL), BETA * D_FF_DENSE ** -0.5),
        'router_w': nrm(ks[15], (N_MOE, D_MODEL, N_EXPERTS), D_MODEL ** -0.5),
        'moe_w_gate': nrm(ks[16], (N_MOE, N_EXPERTS, D_MODEL, D_FF_EXPERT), D_MODEL ** -0.5),
        'moe_w_up': nrm(ks[17], (N_MOE, N_EXPERTS, D_MODEL, D_FF_EXPERT), D_MODEL ** -0.5),
        'moe_w_down': nrm(ks[18], (N_MOE, N_EXPERTS, D_FF_EXPERT, D_MODEL), BETA * D_FF_EXPERT ** -0.5),
        'ln2_g': 1.0 + nrm(ks[19], (DEPTH, D_MODEL), 0.02),
        'ln2_b': nrm(ks[20], (DEPTH, D_MODEL), 0.02),
    }


def reference(x, w_in, lambdas, subln_w, pool_w, pool_scale, w_branch_attn, w_branch_pool, w_out, rel_bias,
              ln1_g, ln1_b, dense_w_gate, dense_w_up, dense_w_down, router_w, moe_w_gate, moe_w_up, moe_w_down,
              ln2_g, ln2_b):
    for l in range(DEPTH):
        lambda_init = 0.8 - 0.6 * math.exp(-0.3 * l)
        mix = hybrid_mixer(x, w_in[l], lambdas[l], subln_w[l], pool_w[l], pool_scale[l],
                           w_branch_attn[l], w_branch_pool[l], w_out[l], rel_bias, lambda_init)
        x = layer_norm(ALPHA * x + mix, ln1_g[l], ln1_b[l])
        if l % 2 == 0:
            f = dense_swiglu(x, dense_w_gate[l // 2], dense_w_up[l // 2], dense_w_down[l // 2])
        else:
            f = moe_swiglu(x, router_w[l // 2], moe_w_gate[l // 2], moe_w_up[l // 2], moe_w_down[l // 2])
        x = layer_norm(ALPHA * x + f, ln2_g[l], ln2_b[l])
    return x
```

```cpp
#include <hip/hip_runtime.h>
#include <hip/hip_bf16.h>
#include <cstdio>
#include <cstdint>
#include <cmath>

constexpr int BATCH = 2, SEQ = 8192, TOK = BATCH * SEQ, DM_ = 2048;
constexpr int AW = 1024, PW = 1024, INW = 8192;
constexpr int FFD = 5632, NEXP = 8, FFE = 7168;
constexpr float LN_EPS = 1e-5f;
constexpr float ALPHA = 1.41421356237309515f;

namespace pg8 {
#define PG8_LAS __attribute__((address_space(3)))
typedef unsigned short bf16_t;
typedef short bf16x8 __attribute__((ext_vector_type(8)));
typedef float f32x4 __attribute__((ext_vector_type(4)));
typedef unsigned u32x4 __attribute__((ext_vector_type(4)));
typedef unsigned u32x2 __attribute__((ext_vector_type(2)));
constexpr int BM = 256, BK = 64, HALF = 128, HTB = HALF * BK * 2  , STAGE_BYTES = 8 * HTB, NXCD = 8, WGM = 8;

__host__ __device__ __forceinline__ int lds_byte(int r, int c) { const int st = (r >> 4) * 2 + (c >> 5), rr = r & 15, cc = c & 31, ob = rr * 64 + cc * 2; return st * 1024 + (ob ^ (((ob >> 9) & 1) << 5)); }
__host__ __device__ __forceinline__ void stage_rc(int b, int& R, int& C) { const int st = b / 1024, sb = b % 1024, swz = sb ^ (((sb >> 9) & 1) << 5); R = (st >> 1) * 16 + swz / 64; C = (st & 1) * 32 + (swz % 64) / 2; }
__host__ __device__ __forceinline__ int perm32(int rho) { const int n = rho >> 4, i = rho & 15; return 8 * (i >> 2) + 4 * n + (i & 3); }

struct Unit { int pm, pn, pb, ka; };
struct Gemm { const bf16_t* A; const bf16_t* Bt; int lda, ldb, K; };

struct StaticOrder {
    int nM, nN, nwg, G, c;
    __host__ __device__ void init(int M, int N, int G_, int c_) { nM = M / BM; nN = N / BM; nwg = nM * nN; G = G_; c = c_; }
    __host__ __device__ bool next(int i, Unit& u) const {
        const long L = (long)i * G + c; if (L >= nwg) return false;
        int wgid = (int)L; { const int q = nwg / NXCD, r = nwg % NXCD, xcd = wgid % NXCD, off = wgid / NXCD; wgid = (xcd < r ? xcd * (q + 1) : r * (q + 1) + (xcd - r) * q) + off; }
        const int nig = WGM * nN, gid = wgid / nig, fm = gid * WGM, gsz = (nM - fm) < WGM ? (nM - fm) : WGM;
        u.pm = fm + ((wgid % nig) % gsz); u.pn = (wgid % nig) / gsz; u.pb = u.pn; u.ka = 0; return true;
    }
    __device__ __forceinline__ void a_ready(const Unit&) const {}
    __device__ __forceinline__ void done(const Unit&) const {}
};
struct FoldOrder {
    int c;
    __device__ bool next(int i, Unit& u) const {
        if (i > 0 || c >= 64) return false;
        const int l = c >> 5, g = (c >> 3) & 3, pm = c & 7;
        u.pm = l * 8 + pm; u.pn = g; u.pb = l * 4 + g; u.ka = 256 * g; return true;
    }
    __device__ __forceinline__ void a_ready(const Unit&) const {}
    __device__ __forceinline__ void done(const Unit&) const {}
};
struct MoeOrder {
    int nN, G, c, nwg;
    int n0, n1, n2, n3, n4, n5, n6, n7;
    __device__ __forceinline__ void init(const unsigned (&cnt)[8], int nN_, int G_, int c_) {
        nN = nN_; G = G_; c = c_;
        n0 = (int)((cnt[0] + 255u) >> 8); n1 = (int)((cnt[1] + 255u) >> 8); n2 = (int)((cnt[2] + 255u) >> 8); n3 = (int)((cnt[3] + 255u) >> 8);
        n4 = (int)((cnt[4] + 255u) >> 8); n5 = (int)((cnt[5] + 255u) >> 8); n6 = (int)((cnt[6] + 255u) >> 8); n7 = (int)((cnt[7] + 255u) >> 8);
        nwg = (n0 + n1 + n2 + n3 + n4 + n5 + n6 + n7) * nN_;
    }
    __device__ __forceinline__ bool next(int i, Unit& u) const {
        const long L = (long)i * G + c; if (L >= nwg) return false;
        int wgid = (int)L; { const int q = nwg / NXCD, r = nwg % NXCD, xcd = wgid % NXCD, off = wgid / NXCD; wgid = (xcd < r ? xcd * (q + 1) : r * (q + 1) + (xcd - r) * q) + off; }
        int e = 0, nte = n0, to = 0, pt = n0;
#define MOE_STEP(k, nk) do { if (wgid >= pt * nN) { e = (k); nte = (nk); to = pt; } pt += (nk); } while (0)
        MOE_STEP(1, n1); MOE_STEP(2, n2); MOE_STEP(3, n3); MOE_STEP(4, n4); MOE_STEP(5, n5); MOE_STEP(6, n6); MOE_STEP(7, n7);
#undef MOE_STEP
        const int rem = wgid - to * nN, nig = WGM * nN, gid = rem / nig, fm = gid * WGM, gsz = (nte - fm) < WGM ? (nte - fm) : WGM;
        const int w = rem % nig;
        u.pm = to + fm + (w % gsz); u.pn = w / gsz; u.pb = e * nN + u.pn; u.ka = 0; return true;
    }
    __device__ __forceinline__ void a_ready(const Unit&) const {}
    __device__ __forceinline__ void done(const Unit&) const {}
};

__device__ __forceinline__ unsigned cvt_pk_bf16(float lo, float hi) { unsigned r; asm volatile("v_cvt_pk_bf16_f32 %0, %1, %2" : "=v"(r) : "v"(lo), "v"(hi)); return r; }
__device__ __forceinline__ float sigm(float x) { return __builtin_amdgcn_rcpf(1.0f + __builtin_amdgcn_exp2f(-1.4426950408889634f * x)); }
__device__ __forceinline__ float bflo(unsigned w) { return __uint_as_float(w << 16); }
__device__ __forceinline__ float bfhi(unsigned w) { return __uint_as_float(w & 0xffff0000u); }
__device__ __forceinline__ u32x4 pack8(const f32x4 v0, const f32x4 v1) { u32x4 w; w.x = cvt_pk_bf16(v0[0], v0[1]); w.y = cvt_pk_bf16(v0[2], v0[3]); w.z = cvt_pk_bf16(v1[0], v1[1]); w.w = cvt_pk_bf16(v1[2], v1[3]); return w; }

struct EpiInProj {
    static constexpr bool PERM = true, AFTER_DRAIN = false;
    bf16_t* O; float scale0;
    __device__ __forceinline__ void operator()(const f32x4 (&acc)[2][2][4][2], const Unit& u, int wr, int wc, int fr, int fq) const {
        const int row0 = u.pm * BM + wr * 64 + fr; const int ct = u.pn * BM, t = ct >> 10;
        bf16_t* base = O + (size_t)t * ((size_t)TOK * 1024);
        const int col0 = (ct & 1023) + wc * 32 + 8 * fq;
#pragma unroll
        for (int ai = 0; ai < 2; ++ai)
#pragma unroll
            for (int m = 0; m < 4; ++m) { bf16_t* rowp = base + (size_t)(row0 + ai * HALF + m * 16) * 1024 + col0;
#pragma unroll
                for (int bj = 0; bj < 2; ++bj) { f32x4 v0 = acc[ai][bj][m][0], v1 = acc[ai][bj][m][1];
                    if (t == 0) { v0 = v0 * scale0; v1 = v1 * scale0; }
                    else if (t >= 4) {
#pragma unroll
                        for (int k = 0; k < 4; ++k) { v0[k] = sigm(v0[k]); v1[k] = sigm(v1[k]); } }
                    *(u32x4*)(rowp + bj * HALF) = pack8(v0, v1); } }
    }
};
struct EpiBf16Plain {
    static constexpr bool PERM = true, AFTER_DRAIN = false;
    bf16_t* O; int ldc;
    __device__ __forceinline__ void operator()(const f32x4 (&acc)[2][2][4][2], const Unit& u, int wr, int wc, int fr, int fq) const {
        const int row0 = u.pm * BM + wr * 64 + fr; const int col0 = u.pn * BM + wc * 32 + 8 * fq;
#pragma unroll
        for (int ai = 0; ai < 2; ++ai)
#pragma unroll
            for (int m = 0; m < 4; ++m) { bf16_t* rowp = O + (size_t)(row0 + ai * HALF + m * 16) * ldc + col0;
#pragma unroll
                for (int bj = 0; bj < 2; ++bj) *(u32x4*)(rowp + bj * HALF) = pack8(acc[ai][bj][m][0], acc[ai][bj][m][1]); }
    }
};
struct EpiGateMul {
    static constexpr bool PERM = true, AFTER_DRAIN = false;
    const bf16_t* Gt; float* Mg;
    __device__ __forceinline__ void operator()(const f32x4 (&acc)[2][2][4][2], const Unit& u, int wr, int wc, int fr, int fq) const {
        const int row0 = u.pm * BM + wr * 64 + fr; const int ct = u.pn * BM;
        const bf16_t* gb = Gt + (size_t)(ct >> 10) * ((size_t)TOK * 1024) + (ct & 1023) + wc * 32 + 8 * fq;
        const int col0 = ct + wc * 32 + 8 * fq;
#pragma unroll
        for (int ai = 0; ai < 2; ++ai)
#pragma unroll
            for (int m = 0; m < 4; ++m) { const int r = row0 + ai * HALF + m * 16;
#pragma unroll
                for (int bj = 0; bj < 2; ++bj) { const u32x4 g = *(const u32x4*)(gb + (size_t)r * 1024 + bj * HALF);
                    const f32x4 g0 = {bflo(g.x), bfhi(g.x), bflo(g.y), bfhi(g.y)}, g1 = {bflo(g.z), bfhi(g.z), bflo(g.w), bfhi(g.w)};
                    float* o = Mg + (size_t)r * DM_ + col0 + bj * HALF;
                    *(f32x4*)o = acc[ai][bj][m][0] * g0; *(f32x4*)(o + 4) = acc[ai][bj][m][1] * g1; } }
    }
};
struct EpiGateAcc {
    static constexpr bool PERM = true, AFTER_DRAIN = false;
    const bf16_t* Gt; const float* Mg; bf16_t* Out;
    __device__ __forceinline__ void operator()(const f32x4 (&acc)[2][2][4][2], const Unit& u, int wr, int wc, int fr, int fq) const {
        const int row0 = u.pm * BM + wr * 64 + fr; const int ct = u.pn * BM;
        const bf16_t* gb = Gt + (size_t)(ct >> 10) * ((size_t)TOK * 1024) + (ct & 1023) + wc * 32 + 8 * fq;
        const int col0 = ct + wc * 32 + 8 * fq;
#pragma unroll
        for (int ai = 0; ai < 2; ++ai)
#pragma unroll
            for (int m = 0; m < 4; ++m) { const int r = row0 + ai * HALF + m * 16;
#pragma unroll
                for (int bj = 0; bj < 2; ++bj) { const u32x4 g = *(const u32x4*)(gb + (size_t)r * 1024 + bj * HALF);
                    const f32x4 g0 = {bflo(g.x), bfhi(g.x), bflo(g.y), bfhi(g.y)}, g1 = {bflo(g.z), bfhi(g.z), bflo(g.w), bfhi(g.w)};
                    const float* mi = Mg + (size_t)r * DM_ + col0 + bj * HALF;
                    const f32x4 v0 = *(const f32x4*)mi + acc[ai][bj][m][0] * g0, v1 = *(const f32x4*)(mi + 4) + acc[ai][bj][m][1] * g1;
                    *(u32x4*)(Out + (size_t)r * DM_ + col0 + bj * HALF) = pack8(v0, v1); } }
    }
};
struct EpiRes {
    static constexpr bool PERM = false, AFTER_DRAIN = false;
    const float* base; float* out; float alpha;
    __device__ __forceinline__ void operator()(const f32x4 (&acc)[2][2][4][2], const Unit& u, int wr, int wc, int fr, int fq) const {
        const int row0 = u.pm * BM + wr * 64 + fr; const int col0 = u.pn * BM + wc * 32 + 4 * fq;
#pragma unroll
        for (int ai = 0; ai < 2; ++ai)
#pragma unroll
            for (int m = 0; m < 4; ++m) { const size_t ro = (size_t)(row0 + ai * HALF + m * 16) * DM_ + col0;
#pragma unroll
                for (int bj = 0; bj < 2; ++bj)
#pragma unroll
                    for (int n = 0; n < 2; ++n) { const size_t off = ro + bj * HALF + n * 16; *(f32x4*)(out + off) = *(const f32x4*)(base + off) * alpha + acc[ai][bj][m][n]; } }
    }
};
struct EpiSwiglu {
    static constexpr bool PERM = true, AFTER_DRAIN = false;
    bf16_t* O; int ldo;
    __device__ __forceinline__ void operator()(const f32x4 (&acc)[2][2][4][2], const Unit& u, int wr, int wc, int fr, int fq) const {
        const int row0 = u.pm * BM + wr * 64 + fr; const int col0 = u.pn * HALF + wc * 32 + 8 * fq;
#pragma unroll
        for (int ai = 0; ai < 2; ++ai)
#pragma unroll
            for (int m = 0; m < 4; ++m) { f32x4 h0, h1;
#pragma unroll
                for (int k = 0; k < 4; ++k) { const float g0 = acc[ai][0][m][0][k], g1 = acc[ai][0][m][1][k];
                    h0[k] = g0 * sigm(g0) * acc[ai][1][m][0][k]; h1[k] = g1 * sigm(g1) * acc[ai][1][m][1][k]; }
                *(u32x4*)(O + (size_t)(row0 + ai * HALF + m * 16) * ldo + col0) = pack8(h0, h1); }
    }
};
struct EpiMoeDown {
    static constexpr bool PERM = false, AFTER_DRAIN = false;
    const int* rowmap; const float* roww; float* Y2;
    __device__ __forceinline__ void operator()(const f32x4 (&acc)[2][2][4][2], const Unit& u, int wr, int wc, int fr, int fq) const {
        const int row0 = u.pm * BM + wr * 64 + fr; const int col0 = u.pn * BM + wc * 32 + 4 * fq;
#pragma unroll
        for (int ai = 0; ai < 2; ++ai)
#pragma unroll
            for (int m = 0; m < 4; ++m) { const int r = row0 + ai * HALF + m * 16; const int tm = rowmap[r];
                if (tm >= 0) { const float w = roww[r]; float* o = Y2 + (size_t)tm * DM_ + col0;
#pragma unroll
                    for (int bj = 0; bj < 2; ++bj)
#pragma unroll
                        for (int n = 0; n < 2; ++n) *(f32x4*)(o + bj * HALF + n * 16) = acc[ai][bj][m][n] * w; } }
    }
};

template <class Epi, class Sched, bool ALIGN_EPI = false>
__device__ __forceinline__ void gemm_phase(PG8_LAS unsigned char* lds, const Gemm g, const Sched& S, const Epi& E) {
    const int tid = threadIdx.x, wid = __builtin_amdgcn_readfirstlane(tid >> 6), lane = tid & 63, wr = wid >> 2, wc = wid & 3, fr = lane & 15, fq = lane >> 4;
    const int K = g.K, nt = K / BK;
    unsigned voffA[2], voffB[2];
#pragma unroll
    for (int i = 0; i < 2; ++i) { int R, C; stage_rc(tid * 16 + i * 8192, R, C); const int Rb = Epi::PERM ? ((R & ~31) + perm32(R & 31)) : R;
        voffA[i] = (unsigned)(R * g.lda + C) * 2u; voffB[i] = (unsigned)(Rb * g.ldb + C) * 2u; }
    const size_t kstep = (size_t)(BK * 2);
    const size_t hstepA = (size_t)HALF * g.lda * 2, hstepB = (size_t)HALF * g.ldb * 2;
    const unsigned ldsw = (unsigned)wid * 1024u;
    const int aoff = lds_byte(wr * 64 + fr, fq * 8), boff = lds_byte(wc * 32 + fr, fq * 8);
#define PG8_SA(b, h) (((b) * 2 + (h)) * HTB)
#define PG8_SB(b, h) ((4 + (b) * 2 + (h)) * HTB)
#define PG8_STAGE(bufoff, gbase, voff) do { _Pragma("unroll") for (int _i = 0; _i < 2; ++_i) \
        __builtin_amdgcn_global_load_lds((const unsigned*)((const char*)(gbase) + (voff)[_i]), (PG8_LAS unsigned*)(lds + (bufoff) + ldsw + _i * 8192), 16, 0, 0); } while (0)
#define PG8_LDA(dst, b, h) do { _Pragma("unroll") for (int m = 0; m < 4; ++m) _Pragma("unroll") for (int k = 0; k < 2; ++k) dst[m][k] = *(const PG8_LAS bf16x8*)(lds + PG8_SA(b, h) + aoff + m * 2048 + k * 1024); } while (0)
#define PG8_LDB(dst, b, h) do { _Pragma("unroll") for (int n = 0; n < 2; ++n) _Pragma("unroll") for (int k = 0; k < 2; ++k) dst[n][k] = *(const PG8_LAS bf16x8*)(lds + PG8_SB(b, h) + boff + n * 2048 + k * 1024); } while (0)
#define PG8_MMA(ai, bj, At, Bt) do { __builtin_amdgcn_s_setprio(1); _Pragma("unroll") for (int m = 0; m < 4; ++m) _Pragma("unroll") for (int n = 0; n < 2; ++n) _Pragma("unroll") for (int k = 0; k < 2; ++k) \
        acc[ai][bj][m][n] = __builtin_amdgcn_mfma_f32_16x16x32_bf16(Bt[n][k], At[m][k], acc[ai][bj][m][n], 0, 0, 0); __builtin_amdgcn_s_setprio(0); } while (0)
#define PG8_WAIT_V(n) asm volatile("s_waitcnt vmcnt(" #n ")" ::: "memory")
#define PG8_WAIT_L(n) asm volatile("s_waitcnt lgkmcnt(" #n ")" ::: "memory")
#define PG8_BAR __builtin_amdgcn_s_barrier()
#define PG8_SCHED __builtin_amdgcn_sched_barrier(0)
    Unit cur, nxt; int ui = 0;
    if (!S.next(0, cur)) return;
    f32x4 acc[2][2][4][2];
#pragma unroll
    for (int a = 0; a < 2; ++a)
#pragma unroll
        for (int b = 0; b < 2; ++b)
#pragma unroll
            for (int m = 0; m < 4; ++m)
#pragma unroll
                for (int n = 0; n < 2; ++n) acc[a][b][m][n] = (f32x4){0.f, 0.f, 0.f, 0.f};
    bf16x8 At[4][2], B0[2][2], B1[2][2];
    const char* cA = (const char*)g.A + (size_t)cur.pm * 2 * hstepA + (size_t)cur.ka * 2; const char* cB = (const char*)g.Bt + (size_t)cur.pb * 2 * hstepB;
    S.a_ready(cur);
    PG8_STAGE(PG8_SB(0, 0), cB, voffB); PG8_STAGE(PG8_SB(0, 1), cB + hstepB, voffB); PG8_STAGE(PG8_SA(0, 0), cA, voffA); PG8_STAGE(PG8_SA(0, 1), cA + hstepA, voffA);
    if (wr == 1) PG8_BAR;
    PG8_WAIT_V(2); PG8_BAR;
    PG8_STAGE(PG8_SB(1, 0), cB + kstep, voffB); PG8_STAGE(PG8_SA(1, 0), cA + kstep, voffA); PG8_STAGE(PG8_SB(1, 1), cB + hstepB + kstep, voffB);
    PG8_WAIT_V(6); PG8_BAR;
    for (;;) {
        const bool has_next = S.next(ui + 1, nxt);
        const char* nA = has_next ? (const char*)g.A + (size_t)nxt.pm * 2 * hstepA + (size_t)nxt.ka * 2 : cA; const char* nB = has_next ? (const char*)g.Bt + (size_t)nxt.pb * 2 * hstepB : cB;
        for (int t = 0; t < nt; t += 2) {
            const bool last = (t == nt - 2);
            const char* a1 = cA + (size_t)(t + 1) * kstep;
            const char* a2 = last ? nA : cA + (size_t)(t + 2) * kstep; const char* b2 = last ? nB : cB + (size_t)(t + 2) * kstep;
            const char* a3 = a2 + kstep; const char* b3 = b2 + kstep;
            if (last && has_next) S.a_ready(nxt);
            PG8_LDB(B0, 0, 0); PG8_LDB(B1, 0, 1); PG8_SCHED; PG8_LDA(At, 0, 0); PG8_STAGE(PG8_SA(1, 1), a1 + hstepA, voffA);
            PG8_WAIT_V(8); PG8_WAIT_L(0); PG8_BAR; PG8_MMA(0, 0, At, B0); PG8_MMA(0, 1, At, B1); PG8_BAR; PG8_SCHED;
            PG8_LDA(At, 0, 1); PG8_STAGE(PG8_SB(0, 0), b2, voffB); PG8_STAGE(PG8_SB(0, 1), b2 + hstepB, voffB); PG8_STAGE(PG8_SA(0, 0), a2, voffA);
            PG8_WAIT_V(8); PG8_WAIT_L(0); PG8_BAR; PG8_MMA(1, 0, At, B0); PG8_MMA(1, 1, At, B1); PG8_BAR; PG8_SCHED;
            PG8_LDB(B0, 1, 0); PG8_LDB(B1, 1, 1); PG8_SCHED; PG8_LDA(At, 1, 0); PG8_STAGE(PG8_SA(0, 1), a2 + hstepA, voffA);
            PG8_WAIT_V(8); PG8_WAIT_L(0); PG8_BAR; PG8_MMA(0, 0, At, B0); PG8_MMA(0, 1, At, B1); PG8_BAR; PG8_SCHED;
            PG8_LDA(At, 1, 1); PG8_STAGE(PG8_SB(1, 0), b3, voffB); PG8_STAGE(PG8_SB(1, 1), b3 + hstepB, voffB); PG8_STAGE(PG8_SA(1, 0), a3, voffA);
            PG8_WAIT_V(8); PG8_WAIT_L(0); PG8_BAR; PG8_MMA(1, 0, At, B0); PG8_MMA(1, 1, At, B1); PG8_BAR; PG8_SCHED;
        }
        if constexpr (ALIGN_EPI) { if (wr == 0) PG8_BAR; }
        E(acc, cur, wr, wc, fr, fq); S.done(cur);
        if (!has_next) break;
#pragma unroll
        for (int a = 0; a < 2; ++a)
#pragma unroll
            for (int b = 0; b < 2; ++b)
#pragma unroll
                for (int m = 0; m < 4; ++m)
#pragma unroll
                    for (int n = 0; n < 2; ++n) acc[a][b][m][n] = (f32x4){0.f, 0.f, 0.f, 0.f};
        cur = nxt; cA = nA; cB = nB; ++ui;
        if constexpr (ALIGN_EPI) { if (wr == 1) PG8_BAR; }
    }
    PG8_WAIT_V(0);
    if constexpr (!ALIGN_EPI) { if (wr == 0) PG8_BAR; }
    PG8_BAR;
#undef PG8_SA
#undef PG8_SB
#undef PG8_STAGE
#undef PG8_LDA
#undef PG8_LDB
#undef PG8_MMA
#undef PG8_WAIT_V
#undef PG8_WAIT_L
#undef PG8_BAR
#undef PG8_SCHED
}
}

namespace attn_body {
using bf16=__hip_bfloat16;
using bf16x8=__attribute__((ext_vector_type(8)))short;
using s16x4=__attribute__((ext_vector_type(4)))short;
using f32x16=__attribute__((ext_vector_type(16)))float;
using u32x4=__attribute__((ext_vector_type(4)))unsigned;
constexpr int SEQ=8192,D=64,DM=1024;
constexpr int NW=8,QBLK=32,QB=QBLK*NW,KVBLK=64,NQB=SEQ/QB;
constexpr int ATTN_PITCH=DM, ATTN_UNIT_ROWS=QB;
__device__ __forceinline__ int crow(int r,int hi){return (r&3)+8*(r>>2)+4*hi;}
#define SBAR() __builtin_amdgcn_sched_barrier(0)
typedef __attribute__((address_space(3))) const float* lds_fptr;
__device__ __forceinline__ void cmask_bias(f32x16&p0,f32x16&p1,int jb,int qrel,int hi,lds_fptr tbl){
  const float NEG=-INFINITY; const int nb=qrel-64*jb-4*hi;
  #pragma unroll
  for(int r=0;r<16;++r){const int n0=nb-((r&3)+8*(r>>2)), n1=n0-32;
    const int i0=n0<0?0:(n0>127?127:n0), i1=n1<0?0:(n1>127?127:n1);
    const float b0=tbl[i0], b1=tbl[i1];
    p0[r]=(n0<0)?NEG:(p0[r]+b0); p1[r]=(n1<0)?NEG:(p1[r]+b1);
    if((r&3)==3) asm volatile("":::"memory");}
}

constexpr int NSLOT=3, SLOTB=8192;
constexpr int LDS_K=0, LDS_V=NSLOT*SLOTB, LDS_WS=2*NSLOT*SLOTB, LDS_OST=LDS_WS+NW*64*4, LDS_BYTES=LDS_OST+NW*4096;
constexpr float C2=0.125f*1.4426950408889634f;
__device__ __forceinline__ void glds16(const void*gsrc,unsigned lds_dst){unsigned keep;
  asm volatile("s_mov_b32 %0, m0\n\ts_mov_b32 m0, %2\n\ts_nop 0\n\tglobal_load_lds_dwordx4 %1, off\n\ts_mov_b32 m0, %0":"=&s"(keep):"v"(gsrc),"s"(lds_dst):"memory");}
__device__ __forceinline__ float max3f(float a,float b,float c){float r;asm("v_max3_f32 %0, %1, %2, %3":"=v"(r):"v"(a),"v"(b),"v"(c));return r;}
__device__ __forceinline__ float max2f(float a,float b){float r;asm("v_max_f32_e32 %0, %1, %2":"=v"(r):"v"(a),"v"(b));return r;}
__device__ __forceinline__ float fadd_s(float a,float b){float r;asm("v_add_f32_e32 %0, %1, %2":"=v"(r):"v"(a),"v"(b));return r;}
__device__ __forceinline__ float fsub_s(float a,float b){float r;asm("v_sub_f32_e32 %0, %1, %2":"=v"(r):"v"(a),"v"(b));return r;}
typedef float f32x2_t __attribute__((ext_vector_type(2))); typedef __bf16 bf16x2_t __attribute__((ext_vector_type(2)));
__device__ __forceinline__ unsigned cvtpk_s(float lo,float hi){f32x2_t v={lo,hi};bf16x2_t b=__builtin_convertvector(v,bf16x2_t);return __builtin_bit_cast(unsigned,b);}
#define WAIT_BAR(N) asm volatile("s_waitcnt vmcnt(" #N ") lgkmcnt(0)\n\ts_barrier":::"memory")

__device__ __forceinline__ void qkt(f32x16&p0,f32x16&p1,const char*Kslot,const bf16x8*qr,const f32x16&negm,int r32,int hi){
  const char*kb=Kslot+hi*1024+r32*16;
  #pragma unroll
  for(int d0=0;d0<4;++d0){
    const bf16x8 b0=*reinterpret_cast<const bf16x8*>(kb+d0*2048);
    const bf16x8 b1=*reinterpret_cast<const bf16x8*>(kb+d0*2048+512);
    if(d0==0){p0=__builtin_amdgcn_mfma_f32_32x32x16_bf16(b0,qr[0],negm,0,0,0);p1=__builtin_amdgcn_mfma_f32_32x32x16_bf16(b1,qr[0],negm,0,0,0);}
    else{p0=__builtin_amdgcn_mfma_f32_32x32x16_bf16(b0,qr[d0],p0,0,0,0);p1=__builtin_amdgcn_mfma_f32_32x32x16_bf16(b1,qr[d0],p1,0,0,0);}}
}
typedef __attribute__((address_space(3))) const char* lds_cptr;
typedef short v4i16_t __attribute__((ext_vector_type(4)));
__device__ __forceinline__ void kload8(bf16x8*kf,lds_cptr kp){
  kf[0]=*(const __attribute__((address_space(3))) bf16x8*)(kp);      kf[1]=*(const __attribute__((address_space(3))) bf16x8*)(kp+512);
  kf[2]=*(const __attribute__((address_space(3))) bf16x8*)(kp+2048); kf[3]=*(const __attribute__((address_space(3))) bf16x8*)(kp+2560);
  kf[4]=*(const __attribute__((address_space(3))) bf16x8*)(kp+4096); kf[5]=*(const __attribute__((address_space(3))) bf16x8*)(kp+4608);
  kf[6]=*(const __attribute__((address_space(3))) bf16x8*)(kp+6144); kf[7]=*(const __attribute__((address_space(3))) bf16x8*)(kp+6656);
}
__device__ __forceinline__ void kload2(bf16x8*kf,lds_cptr kp,int j){ kf[2*j]=*(const __attribute__((address_space(3))) bf16x8*)(kp+j*2048); kf[2*j+1]=*(const __attribute__((address_space(3))) bf16x8*)(kp+j*2048+512); }
__device__ __forceinline__ s16x4 vtr(lds_cptr p){ return __builtin_bit_cast(s16x4,__builtin_amdgcn_ds_read_tr16_b64_v4i16((__attribute__((address_space(3))) v4i16_t*)p)); }
__device__ __forceinline__ float rowmax(const f32x16&p0,const f32x16&p1){
  float a=max3f(p0[0],p0[1],p1[0]),b=max3f(p0[2],p0[3],p1[1]);a=max3f(a,p1[2],p1[3]);
  #pragma unroll
  for(int r=4;r<16;r+=4){a=max3f(a,p0[r],p0[r+1]);b=max3f(b,p0[r+2],p0[r+3]);a=max3f(a,p1[r],p1[r+1]);b=max3f(b,p1[r+2],p1[r+3]);}
  const float m=max2f(a,b);
  auto rr=__builtin_amdgcn_permlane32_swap(__float_as_uint(m),__float_as_uint(m),false,false);
  return max2f(__uint_as_float(rr[0]),__uint_as_float(rr[1]));
}
__device__ __forceinline__ void pv(f32x16*o,int vb,bf16x8 pa0,bf16x8 pa1,bf16x8 pa2,bf16x8 pa3){
  #pragma unroll
  for(int d0=0;d0<2;++d0){s16x4 lo[4],hi[4];
    #pragma unroll
    for(int ks=0;ks<4;++ks){
      asm volatile("ds_read_b64_tr_b16 %0,%1 offset:%c2":"=&v"(lo[ks]):"v"(vb),"i"(d0*4096+ks*1024):"memory");
      asm volatile("ds_read_b64_tr_b16 %0,%1 offset:%c2":"=&v"(hi[ks]):"v"(vb),"i"(d0*4096+ks*1024+512):"memory");}
    asm volatile("s_waitcnt lgkmcnt(0)":::"memory");SBAR();
    #define PK(k) (bf16x8){lo[k][0],lo[k][1],lo[k][2],lo[k][3],hi[k][0],hi[k][1],hi[k][2],hi[k][3]}
    o[d0]=__builtin_amdgcn_mfma_f32_32x32x16_bf16(pa0,PK(0),o[d0],0,0,0);
    o[d0]=__builtin_amdgcn_mfma_f32_32x32x16_bf16(pa1,PK(1),o[d0],0,0,0);
    o[d0]=__builtin_amdgcn_mfma_f32_32x32x16_bf16(pa2,PK(2),o[d0],0,0,0);
    o[d0]=__builtin_amdgcn_mfma_f32_32x32x16_bf16(pa3,PK(3),o[d0],0,0,0);
    #undef PK
  }
}

#ifndef ATTN_STORE16
#define ATTN_STORE16(p,v) (*(u32x4*)(p)=(v))
#endif
template<int THRL> __device__ __forceinline__ void attn_unit(int b,int qcol,int vcol,int qb,const bf16*Q,const bf16*__restrict__ K,const bf16*__restrict__ V,bf16*O,char*shm,lds_fptr tbl){
  int tid_=threadIdx.x; asm volatile("":"+v"(tid_));
  const int tid=tid_,lane=tid&63,r32=lane&31,hi=lane>>5; const int wid=__builtin_amdgcn_readfirstlane(tid>>6);
  const long rowbase=(long)b*SEQ; const int q0=qb*QB;
  const bf16*Qw=Q+(rowbase+q0+wid*QBLK)*DM+qcol;
  const bf16*Kh=K+rowbase*DM+qcol,*Vh=V+rowbase*DM+vcol;
  const unsigned lds0=(unsigned)(uintptr_t)shm;
  float*wsf=(float*)(shm+LDS_WS)+wid*64;
  const bf16*ksrc=Kh+(long)lane*DM+wid*8;
  const bf16*vsrc=Vh+(long)(16*(wid&3)+(lane>>2))*DM+(wid>>2)*32+(lane&3)*8;
  const unsigned kdst=lds0+LDS_K+wid*1024, vdst=lds0+LDS_V+wid*1024;
  #define DMA_K(t,slot) glds16(ksrc+(long)(t)*KVBLK*DM,(unsigned)__builtin_amdgcn_readfirstlane(kdst+(slot)))
  #define DMA_V(t,slot) glds16(vsrc+(long)(t)*KVBLK*DM,(unsigned)__builtin_amdgcn_readfirstlane(vdst+(slot)))
  const int vb0=(int)(lds0+LDS_V)+((lane>>4)&1)*32+(lane&3)*8+(4*hi+((lane&15)>>2))*64;
  const char*Kbase=shm+LDS_K; bf16x8 kf[8];
  const lds_cptr shm3=(lds_cptr)shm; const lds_cptr kp0=shm3+LDS_K+hi*1024+r32*16; const lds_cptr vp0=shm3+LDS_V+((lane>>4)&1)*32+(lane&3)*8+(4*hi+((lane&15)>>2))*64;
  const int NT=(q0+QB)/KVBLK;
  DMA_K(0,0);DMA_V(0,0);DMA_K(1,SLOTB);
  bf16x8 qr[4];
  #pragma unroll
  for(int d0=0;d0<4;++d0)qr[d0]=*reinterpret_cast<const bf16x8*>(&Qw[(long)r32*DM+d0*16+hi*8]);
  float mhat=0.f,l_reg=0.f;f32x16 o[2];o[0]=f32x16{};o[1]=f32x16{};f32x16 negm=f32x16{};asm volatile("":"+v"(negm));
  const int qrel=wid*QBLK+r32;
  #define CMASK(P0,P1,t) do{int jb_=(t)-(NT-4); if(jb_>=-2)cmask_bias(P0,P1,jb_,qrel,hi,tbl);}while(0)
  bool resc=false;
  #define START(P0,P1) do{ const float rm=rowmax(P0,P1); resc=false; \
    { const float dl=rm; mhat=fadd_s(mhat,dl); \
      _Pragma("unroll") for(int r=0;r<16;++r){P0[r]=fsub_s(P0[r],dl);P1[r]=fsub_s(P1[r],dl);} \
      _Pragma("unroll") for(int r=0;r<16;++r)negm[r]=-mhat; asm volatile("":"+v"(negm)); } \
    _Pragma("unroll") for(int r=0;r<16;++r)P0[r]=__builtin_amdgcn_exp2f(P0[r]); }while(0)
  #define RESC() do{ if(resc){ asm volatile("s_waitcnt lgkmcnt(0)":::"memory"); \
      _Pragma("unroll") for(int d_=0;d_<2;++d_) _Pragma("unroll") for(int r=0;r<16;++r)o[d_][r]*=wsf[crow(r,hi)]; } }while(0)
  f32x16 pA0,pA1,pB0,pB1;
  int sl_prev=0,sl_cur=0,sl_next=SLOTB;
  #define ROT() do{sl_prev=sl_cur;sl_cur=sl_next;sl_next=(sl_next==(NSLOT-1)*SLOTB)?0:sl_next+SLOTB;}while(0)
  DMA_K(2,2*SLOTB);
  WAIT_BAR(3);
  qkt(pA0,pA1,Kbase,qr,negm,r32,hi);asm volatile("s_nop 15\n\ts_nop 7":"+v"(pA0),"+v"(pA1));CMASK(pA0,pA1,0);
  START(pA0,pA1);
  _Pragma("unroll") for(int r=0;r<16;++r)pA1[r]=__builtin_amdgcn_exp2f(pA1[r]);
  WAIT_BAR(0);
  DMA_K(3,0);DMA_V(1,SLOTB);
  ROT();
  kload8(kf,kp0+sl_cur);
  WAIT_BAR(2);
  s16x4 vlo[8],vhi[8]; u32x4 pw0,pw1,pw2,pw3;
  #define PKW(P,B) cvtpk_s(P[B],P[B+1])
  #define PAF(k) __builtin_bit_cast(bf16x8,pw##k)
  #define VFR(i) (bf16x8){vlo[i][0],vlo[i][1],vlo[i][2],vlo[i][3],vhi[i][0],vhi[i][1],vhi[i][2],vhi[i][3]}
  #define PIN(x) asm volatile("":"+v"(x))
  #define MX3(a,b,c) __builtin_fmaxf(__builtin_fmaxf((a),(b)),(c))
  #define GAPA(MF,A0,A1,A2,A3,W0,W1,PW) do{ MF; sacc+=A0; sacc+=A1; sacc+=A2; sacc+=A3; PIN(sacc); W0; W1; PIN(PW); SBAR(); }while(0)
  #define EX(v) __builtin_amdgcn_exp2f(v)
  #define GAPB(MF,X,B) do{ MF; X[B]=EX(X[B]); X[B+1]=EX(X[B+1]); X[B+2]=EX(X[B+2]); X[B+3]=EX(X[B+3]); PIN(X); SBAR(); }while(0)
  #define VRD(i) do{ vlo[i]=vtr(vp_+(((i)>>2)*4096+((i)&3)*1024)); vhi[i]=vtr(vp_+(((i)>>2)*4096+((i)&3)*1024+512)); }while(0)
  #define KRD(G,j) do{ if(G){ kload2(kf,kp0+sl_next,j); SBAR(); } }while(0)
  #define STEP(C0,C1,P0,P1,t,GK,GV,GL) do{ SBAR(); \
    const lds_cptr vp_=vp0+sl_prev; \
    VRD(0); SBAR(); float sacc=(P0[0]+P0[1]); \
    GAPA(C0=__builtin_amdgcn_mfma_f32_32x32x16_bf16(kf[0],qr[0],negm,0,0,0), P0[2],P0[3],P0[4],P0[5],     pw0[0]=PKW(P0,0), pw0[1]=PKW(P0,2), pw0); \
    VRD(4); SBAR(); GAPA(C1=__builtin_amdgcn_mfma_f32_32x32x16_bf16(kf[1],qr[0],negm,0,0,0), P0[6],P0[7],P0[8],P0[9],     pw0[2]=PKW(P0,4), pw0[3]=PKW(P0,6), pw0); \
    VRD(1); SBAR(); GAPA(C0=__builtin_amdgcn_mfma_f32_32x32x16_bf16(kf[2],qr[1],C0,0,0,0),   P0[10],P0[11],P0[12],P0[13], pw1[0]=PKW(P0,8), pw1[1]=PKW(P0,10), pw1); \
    VRD(5); SBAR(); GAPA(C1=__builtin_amdgcn_mfma_f32_32x32x16_bf16(kf[3],qr[1],C1,0,0,0),   P0[14],P0[15],P1[0],P1[1],   pw1[2]=PKW(P0,12),pw1[3]=PKW(P0,14), pw1); \
    VRD(2); SBAR(); GAPA(C0=__builtin_amdgcn_mfma_f32_32x32x16_bf16(kf[4],qr[2],C0,0,0,0),   P1[2],P1[3],P1[4],P1[5],     pw2[0]=PKW(P1,0), pw2[1]=PKW(P1,2), pw2); \
    VRD(6); SBAR(); GAPA(C1=__builtin_amdgcn_mfma_f32_32x32x16_bf16(kf[5],qr[2],C1,0,0,0),   P1[6],P1[7],P1[8],P1[9],     pw2[2]=PKW(P1,4), pw2[3]=PKW(P1,6), pw2); \
    VRD(3); SBAR(); GAPA(C0=__builtin_amdgcn_mfma_f32_32x32x16_bf16(kf[6],qr[3],C0,0,0,0),   P1[10],P1[11],P1[12],P1[13], pw3[0]=PKW(P1,8), pw3[1]=PKW(P1,10), pw3); \
    VRD(7); SBAR(); GAPA(C1=__builtin_amdgcn_mfma_f32_32x32x16_bf16(kf[7],qr[3],C1,0,0,0),   P1[14],P1[15],0.f,0.f,       pw3[2]=PKW(P1,12),pw3[3]=PKW(P1,14), pw3); \
    l_reg+=sacc; \
    if(GK){DMA_K((t)+3,sl_cur);} if(GV){DMA_V((t)+1,sl_next);} \
    CMASK(C0,C1,t); \
    { float a=MX3(C0[0],C0[1],C1[0]),b=MX3(C0[2],C0[3],C1[1]); a=MX3(a,C1[2],C1[3]); \
      _Pragma("unroll") for(int r=4;r<16;r+=4){a=MX3(a,C0[r],C0[r+1]);b=MX3(b,C0[r+2],C0[r+3]);a=MX3(a,C1[r],C1[r+1]);b=MX3(b,C1[r+2],C1[r+3]);} \
      float rm=__builtin_fmaxf(a,b); { auto rr=__builtin_amdgcn_permlane32_swap(__float_as_uint(rm),__float_as_uint(rm),false,false); rm=__builtin_fmaxf(__uint_as_float(rr[0]),__uint_as_float(rr[1])); } \
      resc=false; \
      if(__builtin_expect(__any(rm>(float)THRL),0)){ const float dl=__builtin_fmaxf(rm,0.f); mhat+=dl; \
        _Pragma("unroll") for(int r=0;r<16;++r){C0[r]-=dl;C1[r]-=dl;} \
        _Pragma("unroll") for(int r=0;r<16;++r)negm[r]=-mhat; asm volatile("":"+v"(negm)); \
        const float f=__builtin_amdgcn_exp2f(-dl); l_reg*=f; if(hi==0)wsf[r32]=f; resc=true; } } \
    SBAR(); \
    GAPB(o[0]=__builtin_amdgcn_mfma_f32_32x32x16_bf16(PAF(0),VFR(0),o[0],0,0,0), C0,0); \
    GAPB(o[1]=__builtin_amdgcn_mfma_f32_32x32x16_bf16(PAF(0),VFR(4),o[1],0,0,0), C0,4); \
    KRD(GL,0); GAPB(o[0]=__builtin_amdgcn_mfma_f32_32x32x16_bf16(PAF(1),VFR(1),o[0],0,0,0), C0,8); \
    KRD(GL,1); GAPB(o[1]=__builtin_amdgcn_mfma_f32_32x32x16_bf16(PAF(1),VFR(5),o[1],0,0,0), C0,12); \
    KRD(GL,2); GAPB(o[0]=__builtin_amdgcn_mfma_f32_32x32x16_bf16(PAF(2),VFR(2),o[0],0,0,0), C1,0); \
    KRD(GL,3); GAPB(o[1]=__builtin_amdgcn_mfma_f32_32x32x16_bf16(PAF(2),VFR(6),o[1],0,0,0), C1,4); \
    GAPB(o[0]=__builtin_amdgcn_mfma_f32_32x32x16_bf16(PAF(3),VFR(3),o[0],0,0,0), C1,8); \
    GAPB(o[1]=__builtin_amdgcn_mfma_f32_32x32x16_bf16(PAF(3),VFR(7),o[1],0,0,0), C1,12); \
    }while(0)
  int t=1;
  #undef CMASK
  #define CMASK(P0,P1,t) do{}while(0)
  for(;t+7<NT;t+=2){
    STEP(pB0,pB1,pA0,pA1,t,true,true,true);     WAIT_BAR(2); RESC(); ROT();
    STEP(pA0,pA1,pB0,pB1,t+1,true,true,true);   WAIT_BAR(2); RESC(); ROT();
  }
  #undef CMASK
  #define CMASK(P0,P1,t) do{int jb_=(t)-(NT-4); if(jb_>=-2)cmask_bias(P0,P1,jb_,qrel,hi,tbl);}while(0)
  #define ENDW(tt) do{ if((tt)+3<NT){WAIT_BAR(2);} else if((tt)+2<NT){WAIT_BAR(1);} else {WAIT_BAR(0);} }while(0)
  for(;t+1<NT;t+=2){
    STEP(pB0,pB1,pA0,pA1,t,(t+3<NT),(t+1<NT),(t+1<NT));       ENDW(t);   RESC(); ROT();
    STEP(pA0,pA1,pB0,pB1,t+1,(t+4<NT),(t+2<NT),(t+2<NT));     ENDW(t+1); RESC(); ROT();
  }
  STEP(pB0,pB1,pA0,pA1,NT-1,false,false,false); RESC();
  { float sacc=pB0[0]+pB0[1]; _Pragma("unroll") for(int r=2;r<16;++r)sacc+=pB0[r]; _Pragma("unroll") for(int r=0;r<16;++r)sacc+=pB1[r]; l_reg+=sacc;
    pw0=(u32x4){PKW(pB0,0),PKW(pB0,2),PKW(pB0,4),PKW(pB0,6)};pw1=(u32x4){PKW(pB0,8),PKW(pB0,10),PKW(pB0,12),PKW(pB0,14)};pw2=(u32x4){PKW(pB1,0),PKW(pB1,2),PKW(pB1,4),PKW(pB1,6)};pw3=(u32x4){PKW(pB1,8),PKW(pB1,10),PKW(pB1,12),PKW(pB1,14)};
    SBAR(); pv(o,vb0+sl_cur,PAF(0),PAF(1),PAF(2),PAF(3)); }
  #undef PKW
  #undef PAF
  #undef VFR
  #undef PIN
  #undef MX3
  #undef GAPA
  #undef GAPB
  #undef EX
  #undef VRD
  #undef KRD
  #undef STEP
  #undef ENDW
  {auto rr=__builtin_amdgcn_permlane32_swap(__float_as_uint(l_reg),__float_as_uint(l_reg),false,false);l_reg=__uint_as_float(rr[0])+__uint_as_float(rr[1]);}
  if(hi==0)wsf[32+r32]=l_reg;asm volatile("s_waitcnt lgkmcnt(0)":::"memory");
  float rli[16];
  #pragma unroll
  for(int r=0;r<16;++r)rli[r]=__builtin_amdgcn_rcpf(wsf[32+crow(r,hi)]);
  bf16*Ow=O+(rowbase+q0+wid*QBLK)*DM+vcol;
  { bf16*stg=(bf16*)(shm+LDS_OST)+wid*2048;
    #pragma unroll
    for(int r=0;r<16;++r){const int orow=crow(r,hi);
      #pragma unroll
      for(int d0=0;d0<2;++d0)stg[orow*64+d0*32+r32]=__float2bfloat16(o[d0][r]*rli[r]);}
    asm volatile("s_waitcnt lgkmcnt(0)":::"memory");
    #pragma unroll
    for(int i=0;i<4;++i){const int row=i*8+(lane>>3),ch=lane&7; const u32x4 v=*(const u32x4*)(stg+row*64+ch*8); ATTN_STORE16(Ow+(long)row*DM+ch*8,v);} }
  asm volatile("s_waitcnt lgkmcnt(0)\n\ts_barrier":::"memory");
  #undef DMA_K
  #undef DMA_V
  #undef CMASK
  #undef START
  #undef RESC
  #undef ROT
}
constexpr int ATTN_LDS_BYTES=LDS_BYTES;
struct AttnTensors { const bf16* Q; const bf16* K; const bf16* V; bf16* O0; bf16* O1; };
template<int THRL=8> __device__ __forceinline__ void attn_phase(char*lds,const AttnTensors&T,int vcu,int ncu,lds_fptr tbl_all){
  for(int v=vcu; v<256; v+=ncu){
    const int pair=v>>2, s=v&3, b=pair>>5, vh=pair&31, head=vh>>2, c=(vh>>1)&1, j=vh&1;
    #pragma unroll 1
    for(int i=0;i<8;++i){ const int qb=(i&1)?(8*(i>>1)+7-s):(8*(i>>1)+s);
      attn_unit<THRL>(b,head*128+c*64,head*128+j*64,qb,T.Q,T.K,T.V,c?T.O1:T.O0,lds,tbl_all+head*128); }
  }
}
#undef SBAR
#undef WAIT_BAR
}

#define GAS __attribute__((address_space(1)))
#define LAS __attribute__((address_space(3)))
typedef unsigned short bf16;
typedef unsigned v4u __attribute__((ext_vector_type(4)));
typedef float f32x4 __attribute__((ext_vector_type(4)));
typedef short bf16x8 __attribute__((ext_vector_type(8)));
typedef GAS unsigned gu32;
typedef GAS unsigned long long gu64;
#define RLX_AGENT __ATOMIC_RELAXED, __HIP_MEMORY_SCOPE_AGENT
#define LDS_WAIT() asm volatile("s_waitcnt lgkmcnt(0)" ::: "memory")
#define VM_WAIT() asm volatile("s_waitcnt vmcnt(0)" ::: "memory")
__device__ __forceinline__ unsigned long long rt() { return __builtin_amdgcn_s_memrealtime(); }
__device__ __forceinline__ unsigned f2bf(float f) { unsigned u = __builtin_bit_cast(unsigned, f); return (u + 0x7fffu + ((u >> 16) & 1u)) >> 16; }
__device__ __forceinline__ unsigned pk2(float lo, float hi) { return f2bf(lo) | (f2bf(hi) << 16); }

#define XB_TMO      128
#define XB_XCNT(j)  (256  + 64 * (j))
#define XB_XSUB(j)  (1280 + 64 * (j))
#define XB_XGEN(j)  (2304 + 64 * (j))
#define XB_TOP      3328
#define XB_TOPGEN   3392
#define XCD_BAR_WORDS 3456
#define XB_SPIN_CAP (1u << 18)

__device__ __forceinline__ unsigned xb_ld(unsigned* p)              { return __hip_atomic_load(p, __ATOMIC_RELAXED, __HIP_MEMORY_SCOPE_AGENT); }
__device__ __forceinline__ unsigned xb_add(unsigned* p, unsigned v) { return __hip_atomic_fetch_add(p, v, __ATOMIC_RELAXED, __HIP_MEMORY_SCOPE_AGENT); }
__device__ __forceinline__ unsigned xb_xcc_id() { return (unsigned)__builtin_amdgcn_s_getreg((3 << 11) | 20) & 0xFu; }
#define XB_SPIN(cond, bar) do { unsigned _sp = 0; while (cond) { __builtin_amdgcn_s_sleep(1); \
    if ((++_sp & 255u) == 0u) { if (xb_ld(&(bar)[XB_TMO])) break; if (_sp > XB_SPIN_CAP) { atomicAdd(&(bar)[XB_TMO], 1u); break; } } } } while (0)

struct XcdBarrier {
    unsigned* bar; unsigned x;
    volatile LAS unsigned* st;
};

__device__ __forceinline__ XcdBarrier xcd_barrier_post(unsigned* bar, volatile LAS unsigned* st) {
    XcdBarrier b; b.bar = bar; b.x = xb_xcc_id(); b.st = st;
    if (threadIdx.x == 0) (void)xb_add(&bar[XB_XCNT(b.x)], 1u);
    return b;
}
__device__ __forceinline__ void xcd_barrier_complete(unsigned* bar, unsigned x, unsigned& nloc, unsigned& nx) {
    const unsigned G = gridDim.x * gridDim.y * gridDim.z;
    unsigned sum, cnt, mine, sp = 0u;
    for (;;) {
        sum = 0u; cnt = 0u; mine = 0u;
#pragma unroll
        for (unsigned j = 0; j < 16; ++j) { const unsigned c = xb_ld(&bar[XB_XCNT(j)]); sum += c; cnt += (c > 0u) ? 1u : 0u; mine = (j == x) ? c : mine; }
        if (sum == G) break;
        __builtin_amdgcn_s_sleep(1);
        if ((++sp & 255u) == 0u) { if (xb_ld(&bar[XB_TMO])) break; if (sp > XB_SPIN_CAP) { atomicAdd(&bar[XB_TMO], 1u); break; } }
    }
    nloc = mine > 0u ? mine : 1u; nx = cnt > 0u ? cnt : 1u;
}

__device__ __forceinline__ void xcd_barrier(const XcdBarrier& b) {
    asm volatile("s_waitcnt vmcnt(0)" ::: "memory");
    __syncthreads();
    if (threadIdx.x == 0) {
        unsigned* bar = b.bar;
        __builtin_amdgcn_s_waitcnt(0);
        unsigned nloc = b.st[0], nx = b.st[1];
        if (nloc == 0u) { xcd_barrier_complete(bar, b.x, nloc, nx); b.st[0] = nloc; b.st[1] = nx; }
        const unsigned old = xb_add(&bar[XB_XSUB(b.x)], 1u);
        const unsigned gen = old / nloc;
        if (old + 1u == (gen + 1u) * nloc) {
            __builtin_amdgcn_fence(__ATOMIC_RELEASE, "agent");
            asm volatile("s_waitcnt vmcnt(0)" ::: "memory");
            const unsigned og = xb_add(&bar[XB_TOP], 1u);
            const unsigned tg = og / nx;
            if (og + 1u == (tg + 1u) * nx) xb_add(&bar[XB_TOPGEN], 1u);
            else XB_SPIN(xb_ld(&bar[XB_TOPGEN]) == tg, bar);
            __builtin_amdgcn_fence(__ATOMIC_ACQUIRE, "agent");
            xb_add(&bar[XB_XGEN(b.x)], 1u);
            asm volatile("s_waitcnt vmcnt(0)" ::: "memory");
        } else {
            XB_SPIN(xb_ld(&bar[XB_XGEN(b.x)]) == gen, bar);
            __builtin_amdgcn_fence(__ATOMIC_ACQUIRE, "agent");
            asm volatile("s_waitcnt vmcnt(0)" ::: "memory");
        }
    }
    __syncthreads();
}

constexpr int NWAVES = 8;
constexpr int NPHASE = 22;
#ifndef MK_N_LAUNCHES
#define MK_N_LAUNCHES 22
#endif
constexpr int N_LAUNCHES = MK_N_LAUNCHES;
static_assert(N_LAUNCHES == 1 || N_LAUNCHES == NPHASE, "MK_N_LAUNCHES is 1 or NPHASE");

constexpr size_t MiB = 1u << 20;
constexpr size_t WS_CTL = 0, CTL_ZERO_BYTES = 1 * MiB;
constexpr size_t WS_TAB = 1 * MiB;
constexpr size_t WS_TOKINFO = 2 * MiB;
constexpr size_t WS_ROWMAP = 2 * MiB + 512 * 1024, WS_ROWW = 2 * MiB + 768 * 1024, WS_BBASE = 3 * MiB;
constexpr size_t WS_WIN = 4 * MiB, WS_WBA = 68 * MiB, WS_WBP = 76 * MiB, WS_WBPF = 84 * MiB, WS_WOUT = 92 * MiB, WS_POOLB = 108 * MiB;
constexpr size_t WS_WGU_D = 110 * MiB, WS_WD_D = 154 * MiB, WS_WGU_E = 176 * MiB, WS_WD_E = 624 * MiB, WS_AB = 848 * MiB;
constexpr size_t WS_H = WS_AB, WS_XB = WS_AB + 128 * MiB, WS_O0 = WS_AB + 192 * MiB, WS_O1 = WS_AB + 224 * MiB, WS_AO = WS_AB + 256 * MiB, WS_ZB = WS_AB + 288 * MiB;
constexpr size_t WS_MG = WS_AB + 320 * MiB, WS_MERGED = WS_AB + 448 * MiB, WS_ACT_D = WS_AB + 192 * MiB, WS_ACT_E = WS_AB + 128 * MiB;
constexpr size_t WS_QKV = WS_AB + 604 * MiB, WS_Y = WS_QKV, WS_XS = WS_QKV, WS_Y2 = WS_QKV, WS_END = WS_AB + 860 * MiB;
constexpr int MAXROWS = 34816;
static_assert(WS_WIN + 2 * (size_t)INW * DM_ * 2 <= WS_WBA && WS_WOUT + 2 * (size_t)DM_ * DM_ * 2 <= WS_POOLB && WS_WGU_D + (size_t)2 * FFD * DM_ * 2 <= WS_WD_D && WS_WD_D + (size_t)FFD * DM_ * 2 <= WS_WGU_E, "ws map 1");
static_assert(WS_WGU_E + (size_t)NEXP * 2 * FFE * DM_ * 2 <= WS_WD_E && WS_WD_E + (size_t)NEXP * FFE * DM_ * 2 <= WS_AB, "ws map 2");
static_assert(WS_ACT_E + (size_t)MAXROWS * FFE * 2 <= WS_QKV && WS_XS + (size_t)MAXROWS * DM_ * 2 <= WS_END && WS_Y2 + (size_t)2 * TOK * DM_ * 4 <= WS_END && WS_ACT_D + (size_t)TOK * FFD * 2 <= WS_QKV, "ws map 3");
constexpr int CW_BAR = 4096;
constexpr int CW_CNT = 16384;

constexpr int RING_OFF = 0, RING_BYTES = 131072;
constexpr int ATT_TBL_OFF = 86016;
constexpr int LDSCTL_OFF = RING_BYTES, MISC_OFF = LDSCTL_OFF + 320;
constexpr int LDS_BYTES = 147456;
static_assert(attn_body::ATTN_LDS_BYTES <= ATT_TBL_OFF && ATT_TBL_OFF + 4096 <= RING_BYTES, "attention LDS");

typedef unsigned u32x4_t __attribute__((ext_vector_type(4)));
typedef unsigned u32x2_t __attribute__((ext_vector_type(2)));
__device__ __forceinline__ float wave_sum(float v) {
#pragma unroll
    for (int o = 1; o < 64; o <<= 1) v += __shfl_xor(v, o);
    return v;
}
__device__ __forceinline__ float ld_f32_agent(const float* p) { return __uint_as_float(__hip_atomic_load((const unsigned*)p, __ATOMIC_RELAXED, __HIP_MEMORY_SCOPE_AGENT)); }
__device__ __forceinline__ unsigned ld_u32_agent(const unsigned* p) { return __hip_atomic_load(p, __ATOMIC_RELAXED, __HIP_MEMORY_SCOPE_AGENT); }

struct Args { const float* in[21]; float* out; unsigned char* ws; int ph_lo, ph_hi; };

__device__ __forceinline__ void p0_transpose_item(const float* W, int K, int N, bf16* WT, int mode, LAS float* scr, int item, int lane) {
    const int nblk = N / 32, kb = item / nblk, nb = item % nblk, k0 = 64 * kb, n0 = 32 * nb;
    const int d0 = (mode == 0) ? n0 : (((n0 >> 7) << 8) + (n0 & 127) + (mode == 2 ? 128 : 0));
#pragma unroll 8
    for (int i = 0; i < 32; ++i) { const int kk = 2 * i + (lane >> 5); scr[kk * 33 + (lane & 31)] = W[(size_t)(k0 + kk) * N + n0 + (lane & 31)]; }
    LDS_WAIT(); asm volatile("" ::: "memory");
    const int c = lane & 7;
#pragma unroll
    for (int j = 0; j < 4; ++j) { const int n = (lane >> 3) + 8 * j; const LAS float* s = scr + (8 * c) * 33 + n;
        v4u o; o.x = pk2(s[0 * 33], s[1 * 33]); o.y = pk2(s[2 * 33], s[3 * 33]); o.z = pk2(s[4 * 33], s[5 * 33]); o.w = pk2(s[6 * 33], s[7 * 33]);
        *(GAS v4u*)(WT + (size_t)(d0 + n) * K + k0 + 8 * c) = o; }
    LDS_WAIT(); asm volatile("" ::: "memory");
}

__device__ __forceinline__ void ph_prologue(const Args& a, LAS unsigned char* lds, int vcu, int G, int wave, int lane, int tid) {
    unsigned char* ws = a.ws;
    LAS float* scr = (LAS float*)(lds + RING_OFF + wave * 16384);
    const int gw = vcu * NWAVES + wave, NGW = G * NWAVES;
    for (int jb = 0; jb < 35; ++jb) {
        const float* src; bf16* dst; int K, N, mode = 0;
        if (jb < 2)       { src = a.in[1] + (size_t)jb * DM_ * INW; dst = (bf16*)(ws + WS_WIN) + (size_t)jb * INW * DM_; K = DM_; N = INW; }
        else if (jb < 4)  { const int l = jb - 2; src = a.in[6] + (size_t)l * AW * DM_; dst = (bf16*)(ws + WS_WBA) + (size_t)l * DM_ * AW; K = AW; N = DM_; }
        else if (jb < 6)  { const int l = jb - 4; src = a.in[7] + (size_t)l * PW * DM_; dst = (bf16*)(ws + WS_WBP) + (size_t)l * DM_ * PW; K = PW; N = DM_; }
        else if (jb < 8)  { const int l = jb - 6; src = a.in[8] + (size_t)l * DM_ * DM_; dst = (bf16*)(ws + WS_WOUT) + (size_t)l * DM_ * DM_; K = DM_; N = DM_; }
        else if (jb == 8) { src = a.in[12]; dst = (bf16*)(ws + WS_WGU_D); K = DM_; N = FFD; mode = 1; }
        else if (jb == 9) { src = a.in[13]; dst = (bf16*)(ws + WS_WGU_D); K = DM_; N = FFD; mode = 2; }
        else if (jb == 10) { src = a.in[14]; dst = (bf16*)(ws + WS_WD_D); K = FFD; N = DM_; }
        else if (jb < 19) { const int e = jb - 11; src = a.in[16] + (size_t)e * DM_ * FFE; dst = (bf16*)(ws + WS_WGU_E) + (size_t)e * 2 * FFE * DM_; K = DM_; N = FFE; mode = 1; }
        else if (jb < 27) { const int e = jb - 19; src = a.in[17] + (size_t)e * DM_ * FFE; dst = (bf16*)(ws + WS_WGU_E) + (size_t)e * 2 * FFE * DM_; K = DM_; N = FFE; mode = 2; }
        else              { const int e = jb - 27; src = a.in[18] + (size_t)e * FFE * DM_; dst = (bf16*)(ws + WS_WD_E) + (size_t)e * DM_ * FFE; K = FFE; N = DM_; }
        const int nitems = (K / 64) * (N / 32);
        for (int it = gw; it < nitems; it += NGW) p0_transpose_item(src, K, N, dst, mode, scr, it, lane);
    }
    {
        const float* x = a.in[0]; bf16* xb = (bf16*)(ws + WS_XB);
        const size_t nchunk = (size_t)TOK * DM_ / 8;
        for (size_t i = (size_t)gw * 64 + lane; i < nchunk; i += (size_t)NGW * 64) {
            const f32x4 a0 = *(const GAS f32x4*)(x + 8 * i), a1 = *(const GAS f32x4*)(x + 8 * i + 4);
            v4u o; o.x = pk2(a0.x, a0.y); o.y = pk2(a0.z, a0.w); o.z = pk2(a1.x, a1.y); o.w = pk2(a1.z, a1.w);
            *(GAS v4u*)(xb + 8 * i) = o; }
    }
    {
        const float* pw = a.in[4]; const float* ps = a.in[5]; bf16* pb = (bf16*)(ws + WS_POOLB);
        const int nchunk = 2 * 4 * 256 * 256 / 8;
        for (int i = gw * 64 + lane; i < nchunk; i += NGW * 64) {
            const int f = 8 * i, e0 = f & 255, g = (f >> 16) & 3, l = f >> 18;
            const float* sp = ps + l * PW + 256 * g + e0;
            const f32x4 a0 = *(const GAS f32x4*)(pw + f), a1 = *(const GAS f32x4*)(pw + f + 4), s0 = *(const GAS f32x4*)sp, s1 = *(const GAS f32x4*)(sp + 4);
            v4u o; o.x = pk2(a0.x * s0.x, a0.y * s0.y); o.y = pk2(a0.z * s0.z, a0.w * s0.w); o.z = pk2(a1.x * s1.x, a1.y * s1.y); o.w = pk2(a1.z * s1.z, a1.w * s1.w);
            *(GAS v4u*)(pb + f) = o; }
    }
    if (vcu == 0) {
        float* tab = (float*)(ws + WS_TAB);
        if (wave < 2) {
            const float* lv = a.in[2] + wave * 256;
            const float p = wave_sum(lv[lane] * lv[64 + lane]), q = wave_sum(lv[128 + lane] * lv[192 + lane]);
            const float lam_init = (wave == 0) ? 0.2f : 0.35550906759096926f;
            if (lane == 0) tab[64 * wave] = expf(p) - expf(q) + lam_init;
        }
        const float* rb = a.in[9];
        for (int i = tid; i < 1024; i += NWAVES * 64) {
            const int h = i >> 7, n = i & 127; int bk;
            if (n < 16) bk = n; else { bk = 16 + (int)(logf((float)n / 16.0f) / 2.0794415416798357f * 16.0f); bk = bk > 31 ? 31 : bk; }
            tab[1024 + i] = (rb[bk * 8 + h] - rb[31 * 8 + h]) * 1.4426950408889634f;
        }
    }
}

__device__ __forceinline__ void ph_finalize(const Args& a, int L, int vcu, int G, int wave, int lane) {
    unsigned char* ws = a.ws;
    const int gw = vcu * NWAVES + wave, NGW = G * NWAVES;
    const bf16* O0 = (const bf16*)(ws + WS_O0); const bf16* O1 = (const bf16*)(ws + WS_O1); const bf16* U = (const bf16*)(ws + WS_QKV) + (size_t)3 * TOK * 1024;
    bf16* AO = (bf16*)(ws + WS_AO); bf16* ZB = (bf16*)(ws + WS_ZB);
    const float lam = ld_f32_agent((const float*)(ws + WS_TAB) + 64 * L);
    const float lam_init = (L == 0) ? 0.2f : 0.35550906759096926f;
    const float* sw = a.in[3] + L * 128 + (16 * lane & 127);
    float swv[16];
#pragma unroll
    for (int i = 0; i < 16; ++i) swv[i] = sw[i] * (1.0f - lam_init);
    const int g = lane >> 4, w = 2 << g;
    for (int t = gw; t < TOK; t += NGW) {
        {
            const v4u* p0 = (const v4u*)(O0 + (size_t)t * 1024 + 16 * lane); const v4u* p1 = (const v4u*)(O1 + (size_t)t * 1024 + 16 * lane);
            const v4u a0 = p0[0], a1 = p0[1], b0 = p1[0], b1 = p1[1];
            const unsigned aw[8] = {a0.x, a0.y, a0.z, a0.w, a1.x, a1.y, a1.z, a1.w}, bw[8] = {b0.x, b0.y, b0.z, b0.w, b1.x, b1.y, b1.z, b1.w};
            float o[16]; float ss = 0.f;
#pragma unroll
            for (int i = 0; i < 8; ++i) { o[2 * i] = pg8::bflo(aw[i]) - lam * pg8::bflo(bw[i]); o[2 * i + 1] = pg8::bfhi(aw[i]) - lam * pg8::bfhi(bw[i]); ss += o[2 * i] * o[2 * i] + o[2 * i + 1] * o[2 * i + 1]; }
            ss += __shfl_xor(ss, 1); ss += __shfl_xor(ss, 2); ss += __shfl_xor(ss, 4);
            const float r = 1.0f / sqrtf(ss * (1.0f / 128.0f) + LN_EPS);
            v4u q0, q1;
            q0.x = pk2(o[0] * r * swv[0], o[1] * r * swv[1]); q0.y = pk2(o[2] * r * swv[2], o[3] * r * swv[3]); q0.z = pk2(o[4] * r * swv[4], o[5] * r * swv[5]); q0.w = pk2(o[6] * r * swv[6], o[7] * r * swv[7]);
            q1.x = pk2(o[8] * r * swv[8], o[9] * r * swv[9]); q1.y = pk2(o[10] * r * swv[10], o[11] * r * swv[11]); q1.z = pk2(o[12] * r * swv[12], o[13] * r * swv[13]); q1.w = pk2(o[14] * r * swv[14], o[15] * r * swv[15]);
            v4u* po = (v4u*)(AO + (size_t)t * 1024 + 16 * lane); po[0] = q0; po[1] = q1;
        }
        {
            const int pos = t & (SEQ - 1); const int nwin = (pos + 1) < w ? (pos + 1) : w;
            float s[16];
#pragma unroll
            for (int i = 0; i < 16; ++i) s[i] = 0.f;
            float u0[16];
            for (int d = 0; d < nwin; ++d) {
                const v4u* p = (const v4u*)(U + (size_t)(t - d) * 1024 + 16 * lane); const v4u c0 = p[0], c1 = p[1];
                const unsigned cw[8] = {c0.x, c0.y, c0.z, c0.w, c1.x, c1.y, c1.z, c1.w};
#pragma unroll
                for (int i = 0; i < 8; ++i) { const float lo = pg8::bflo(cw[i]), hi = pg8::bfhi(cw[i]); s[2 * i] += lo; s[2 * i + 1] += hi; if (d == 0) { u0[2 * i] = lo; u0[2 * i + 1] = hi; } }
            }
            const float inv = 1.0f / (float)nwin;
            v4u q0, q1;
            q0.x = pk2(s[0] * inv - u0[0], s[1] * inv - u0[1]); q0.y = pk2(s[2] * inv - u0[2], s[3] * inv - u0[3]); q0.z = pk2(s[4] * inv - u0[4], s[5] * inv - u0[5]); q0.w = pk2(s[6] * inv - u0[6], s[7] * inv - u0[7]);
            q1.x = pk2(s[8] * inv - u0[8], s[9] * inv - u0[9]); q1.y = pk2(s[10] * inv - u0[10], s[11] * inv - u0[11]); q1.z = pk2(s[12] * inv - u0[12], s[13] * inv - u0[13]); q1.w = pk2(s[14] * inv - u0[14], s[15] * inv - u0[15]);
            v4u* po = (v4u*)(ZB + (size_t)t * 1024 + 16 * lane); po[0] = q0; po[1] = q1;
        }
    }
}

__device__ __forceinline__ void ln_core(f32x4 (&v)[8], const float* gp, const float* bp, int lane) {
    float s = 0.f;
#pragma unroll
    for (int j = 0; j < 8; ++j) s += (v[j].x + v[j].y) + (v[j].z + v[j].w);
    const float mean = wave_sum(s) * (1.f / DM_); float s2 = 0.f;
#pragma unroll
    for (int j = 0; j < 8; ++j) { v[j] = v[j] - mean; s2 += (v[j].x * v[j].x + v[j].y * v[j].y) + (v[j].z * v[j].z + v[j].w * v[j].w); }
    const float rstd = 1.f / sqrtf(wave_sum(s2) * (1.f / DM_) + LN_EPS);
#pragma unroll
    for (int j = 0; j < 8; ++j) { const f32x4 gg = *(const f32x4*)(gp + 4 * lane + 256 * j), bb = *(const f32x4*)(bp + 4 * lane + 256 * j); v[j] = v[j] * rstd * gg + bb; }
}
template <int MODE>
__device__ __forceinline__ void ph_ln(const float* src, const float* y2, const float* gp, const float* bp, float* dst, bf16* dstb, int vcu, int G, int wave, int lane) {
    const int gw = vcu * NWAVES + wave, NGW = G * NWAVES;
    for (int m = gw; m < TOK; m += NGW) {
        f32x4 v[8];
        const GAS f32x4* xr = (const GAS f32x4*)(src + (size_t)m * DM_) + lane;
#pragma unroll
        for (int j = 0; j < 8; ++j) v[j] = xr[64 * j];
        if (MODE == 2) {
            const GAS f32x4* ya = (const GAS f32x4*)(y2 + (size_t)(2 * m) * DM_) + lane; const GAS f32x4* yb = (const GAS f32x4*)(y2 + (size_t)(2 * m + 1) * DM_) + lane;
#pragma unroll
            for (int j = 0; j < 8; ++j) v[j] = v[j] * ALPHA + (ya[64 * j] + yb[64 * j]);
        }
        ln_core(v, gp, bp, lane);
        GAS f32x4* o = (GAS f32x4*)(dst + (size_t)m * DM_) + lane;
#pragma unroll
        for (int j = 0; j < 8; ++j) o[64 * j] = v[j];
        if (MODE == 0) {
            GAS u32x2_t* ob = (GAS u32x2_t*)(dstb + (size_t)m * DM_) + lane;
#pragma unroll
            for (int j = 0; j < 8; ++j) { u32x2_t w; w.x = pk2(v[j].x, v[j].y); w.y = pk2(v[j].z, v[j].w); ob[64 * j] = w; }
        }
    }
}
__device__ __forceinline__ void ph_ln_router(const Args& a, const float* src, const float* gp, const float* bp, float* dst, bf16* dstb, LAS unsigned char* lds, volatile LAS unsigned* MISC, int vcu, int G, int wave, int lane, int tid) {
    unsigned char* ws = a.ws;
    const int gw = vcu * NWAVES + wave, NGW = G * NWAVES;
    LAS float* rwT = (LAS float*)(lds + RING_OFF);
    const float* rw = a.in[15];
    for (int i = tid; i < DM_ * NEXP; i += NWAVES * 64) rwT[(i & 7) * DM_ + (i >> 3)] = rw[i];
    if (tid < 8) MISC[16 + tid] = 0u;
    __syncthreads();
    int* tokinfo = (int*)(ws + WS_TOKINFO);
    for (int m = gw; m < TOK; m += NGW) {
        f32x4 v[8];
        const GAS f32x4* xr = (const GAS f32x4*)(src + (size_t)m * DM_) + lane;
#pragma unroll
        for (int j = 0; j < 8; ++j) v[j] = xr[64 * j];
        ln_core(v, gp, bp, lane);
        GAS f32x4* o = (GAS f32x4*)(dst + (size_t)m * DM_) + lane;
#pragma unroll
        for (int j = 0; j < 8; ++j) o[64 * j] = v[j];
        GAS u32x2_t* ob = (GAS u32x2_t*)(dstb + (size_t)m * DM_) + lane;
#pragma unroll
        for (int j = 0; j < 8; ++j) { u32x2_t w; w.x = pk2(v[j].x, v[j].y); w.y = pk2(v[j].z, v[j].w); ob[64 * j] = w; }
        float lg[8];
#pragma unroll
        for (int e = 0; e < 8; ++e) { float p = 0.f;
#pragma unroll
            for (int j = 0; j < 8; ++j) { const f32x4 r4 = *(const LAS f32x4*)(rwT + e * DM_ + 4 * lane + 256 * j); p += (v[j].x * r4.x + v[j].y * r4.y) + (v[j].z * r4.z + v[j].w * r4.w); }
            lg[e] = wave_sum(p); }
        int e0 = 0; float v0 = lg[0];
#pragma unroll
        for (int e = 1; e < 8; ++e) if (lg[e] > v0) { v0 = lg[e]; e0 = e; }
        int e1 = -1; float v1 = -INFINITY;
#pragma unroll
        for (int e = 0; e < 8; ++e) if (e != e0 && lg[e] > v1) { v1 = lg[e]; e1 = e; }
        const float w0 = 1.0f / (1.0f + expf(v1 - v0)), w1 = 1.0f - w0;
        if (lane == 0) {
            const unsigned p0 = __hip_atomic_fetch_add((LAS unsigned*)(MISC + 16 + e0), 1u, __ATOMIC_RELAXED, __HIP_MEMORY_SCOPE_WORKGROUP), p1 = __hip_atomic_fetch_add((LAS unsigned*)(MISC + 16 + e1), 1u, __ATOMIC_RELAXED, __HIP_MEMORY_SCOPE_WORKGROUP);
            int4 r0 = make_int4(e0, (int)p0, e1, (int)p1), r1 = make_int4((int)__float_as_uint(w0), (int)__float_as_uint(w1), 0, 0);
            *(int4*)(tokinfo + (size_t)m * 8) = r0; *(int4*)(tokinfo + (size_t)m * 8 + 4) = r1;
        }
    }
    __syncthreads();
    if (tid < 8) {
        const unsigned n = MISC[16 + tid];
        const unsigned base = __hip_atomic_fetch_add((unsigned*)(ws + WS_CTL) + CW_CNT + 64 * tid, n, __ATOMIC_RELAXED, __HIP_MEMORY_SCOPE_AGENT);
        ((unsigned*)(ws + WS_BBASE))[vcu * 8 + tid] = base;
    }
    __syncthreads();
}
__device__ __forceinline__ void load_cnt(const unsigned char* ws, unsigned (&cnt)[8]) {
#pragma unroll
    for (int e = 0; e < 8; ++e) cnt[e] = (unsigned)__builtin_amdgcn_readfirstlane((int)ld_u32_agent((const unsigned*)(ws + WS_CTL) + CW_CNT + 64 * e));
}
__device__ __forceinline__ void ph_gather(const Args& a, int vcu, int G, int wave, int lane) {
    unsigned char* ws = a.ws;
    const int gw = vcu * NWAVES + wave, NGW = G * NWAVES;
    unsigned cnt[8]; load_cnt(ws, cnt);
    int off[8]; { int o = 0;
#pragma unroll
        for (int e = 0; e < 8; ++e) { off[e] = o; o += (int)((cnt[e] + 255u) & ~255u); } }
    const int* tokinfo = (const int*)(ws + WS_TOKINFO); const unsigned* bbase = (const unsigned*)(ws + WS_BBASE);
    int* rowmap = (int*)(ws + WS_ROWMAP); float* roww = (float*)(ws + WS_ROWW);
    const bf16* Hb = (const bf16*)(ws + WS_XB); bf16* Xs = (bf16*)(ws + WS_XS);
    for (int t = gw; t < TOK; t += NGW) {
        const int4 r0 = *(const int4*)(tokinfo + (size_t)t * 8), r1 = *(const int4*)(tokinfo + (size_t)t * 8 + 4);
        const int blk = (t % NGW) / NWAVES;
        const int e0 = r0.x, e1 = r0.z;
        int o0 = 0, o1 = 0;
#pragma unroll
        for (int e = 0; e < 8; ++e) { if (e == e0) o0 = off[e]; if (e == e1) o1 = off[e]; }
        const int row0 = o0 + (int)bbase[blk * 8 + e0] + r0.y, row1 = o1 + (int)bbase[blk * 8 + e1] + r0.w;
        const GAS v4u* s = (const GAS v4u*)(Hb + (size_t)t * DM_) + lane;
        GAS v4u* d0 = (GAS v4u*)(Xs + (size_t)row0 * DM_) + lane; GAS v4u* d1 = (GAS v4u*)(Xs + (size_t)row1 * DM_) + lane;
#pragma unroll
        for (int j = 0; j < 4; ++j) { const v4u x = s[64 * j]; d0[64 * j] = x; d1[64 * j] = x; }
        if (lane == 0) { rowmap[row0] = 2 * t; roww[row0] = __int_as_float(r1.x); rowmap[row1] = 2 * t + 1; roww[row1] = __int_as_float(r1.y); }
    }
#pragma unroll
    for (int e = 0; e < 8; ++e) {
        const int pend = (int)((cnt[e] + 255u) & ~255u);
        for (int r = (int)cnt[e] + gw; r < pend; r += NGW) {
            const int row = off[e] + r;
            GAS v4u* d = (GAS v4u*)(Xs + (size_t)row * DM_) + lane;
#pragma unroll
            for (int j = 0; j < 4; ++j) d[64 * j] = (v4u){0u, 0u, 0u, 0u};
            if (lane == 0) { rowmap[row] = -1; roww[row] = 0.f; }
        }
    }
}


#ifndef PH_MASK
#define PH_MASK 0xffffffffu
#endif
#define IN(k) (((PH_MASK >> (k)) & 1u) != 0u && lo <= (k) && (k) < hi)
#define SEAM(k) do { if (lo <= (k) && (k) + 1 < hi) xcd_barrier(bar); } while (0)
template <int L>
__device__ __forceinline__ void layer_phases(const Args& args, LAS unsigned char* lds, unsigned char* lds_raw, volatile LAS unsigned* MISC, const XcdBarrier& bar, int lo, int hi, int vcu, int G, int wave, int lane, int tid) {
    unsigned char* ws = args.ws;
    bf16* const WIN = (bf16*)(ws + WS_WIN); bf16* const WBA = (bf16*)(ws + WS_WBA); bf16* const WBPF = (bf16*)(ws + WS_WBPF);
    bf16* const WOUT = (bf16*)(ws + WS_WOUT);
    bf16* const QKV = (bf16*)(ws + WS_QKV); bf16* const XB = (bf16*)(ws + WS_XB); float* const HF = (float*)(ws + WS_H); float* const YF = (float*)(ws + WS_Y);
    float* const MG = (float*)(ws + WS_MG); bf16* const MERGED = (bf16*)(ws + WS_MERGED); bf16* const AO = (bf16*)(ws + WS_AO); bf16* const ZB = (bf16*)(ws + WS_ZB);
    {

        constexpr int pb = 2 + 10 * L;
        const float* xres = (L == 0) ? args.in[0] : (const float*)HF;
        if (IN(pb + 0)) {
            pg8::Gemm g{XB, WIN + (size_t)L * INW * DM_, DM_, DM_, DM_}; pg8::StaticOrder S; S.init(TOK, INW, G, (int)blockIdx.x);
            pg8::EpiInProj E{QKV, attn_body::C2};
            pg8::gemm_phase<pg8::EpiInProj, pg8::StaticOrder, true>(lds + RING_OFF, g, S, E);
        }
        SEAM(pb + 0);
        if (IN(pb + 1)) {
            LAS float* tbl = (LAS float*)(lds + ATT_TBL_OFF);
            const float* tab = (const float*)(ws + WS_TAB) + 1024;
            for (int i = tid; i < 1024; i += NWAVES * 64) tbl[i] = ld_f32_agent(tab + i);
            __syncthreads();
            const attn_body::AttnTensors AT{(const attn_body::bf16*)QKV, (const attn_body::bf16*)(QKV + (size_t)TOK * 1024), (const attn_body::bf16*)(QKV + (size_t)2 * TOK * 1024),
                                            (attn_body::bf16*)(ws + WS_O0), (attn_body::bf16*)(ws + WS_O1)};
            attn_body::attn_phase<8>((char*)lds_raw + RING_OFF, AT, vcu, G, (attn_body::lds_fptr)tbl);
        }
        SEAM(pb + 1);
        if (IN(pb + 2)) { ph_finalize(args, L, vcu, G, wave, lane); }
        SEAM(pb + 2);
        if (IN(pb + 3)) {
            const bf16* GA = QKV + (size_t)4 * TOK * 1024; const bf16* GP = QKV + (size_t)6 * TOK * 1024;
            { pg8::Gemm g{AO, WBA + (size_t)L * DM_ * AW, AW, AW, AW}; pg8::StaticOrder S; S.init(TOK, DM_, G, (int)blockIdx.x);
              pg8::EpiGateMul E{GA, MG};
              pg8::gemm_phase<pg8::EpiGateMul, pg8::StaticOrder, true>(lds + RING_OFF, g, S, E); }
            { pg8::Gemm g{ZB, WBPF + (size_t)L * DM_ * PW, PW, PW, PW}; pg8::StaticOrder S; S.init(TOK, DM_, G, (int)blockIdx.x);
              pg8::EpiGateAcc E{GP, MG, MERGED};
              pg8::gemm_phase<pg8::EpiGateAcc, pg8::StaticOrder, true>(lds + RING_OFF, g, S, E); }
        }
        SEAM(pb + 3);
        if (IN(pb + 4)) {
            pg8::Gemm g{MERGED, WOUT + (size_t)L * DM_ * DM_, DM_, DM_, DM_}; pg8::StaticOrder S; S.init(TOK, DM_, G, (int)blockIdx.x);
            pg8::EpiRes E{xres, YF, ALPHA};
            pg8::gemm_phase<pg8::EpiRes, pg8::StaticOrder, true>(lds + RING_OFF, g, S, E);
        }
        SEAM(pb + 4);
        if constexpr (L == 0) {
            if (IN(pb + 5)) { ph_ln<0>(YF, nullptr, args.in[10], args.in[11], HF, XB, vcu, G, wave, lane); }
            SEAM(pb + 5);
            if (IN(pb + 6)) {
                pg8::Gemm g{XB, (const bf16*)(ws + WS_WGU_D), DM_, DM_, DM_}; pg8::StaticOrder S; S.init(TOK, 2 * FFD, G, (int)blockIdx.x);
                pg8::EpiSwiglu E{(bf16*)(ws + WS_ACT_D), FFD};
                pg8::gemm_phase<pg8::EpiSwiglu, pg8::StaticOrder, true>(lds + RING_OFF, g, S, E);
            }
            SEAM(pb + 6);
            if (IN(pb + 7)) {
                pg8::Gemm g{(const bf16*)(ws + WS_ACT_D), (const bf16*)(ws + WS_WD_D), FFD, FFD, FFD}; pg8::StaticOrder S; S.init(TOK, DM_, G, (int)blockIdx.x);
                pg8::EpiRes E{HF, YF, ALPHA};
                pg8::gemm_phase<pg8::EpiRes, pg8::StaticOrder, true>(lds + RING_OFF, g, S, E);
            }
            SEAM(pb + 7);
            if (IN(pb + 8)) { ph_ln<0>(YF, nullptr, args.in[19], args.in[20], HF, XB, vcu, G, wave, lane); }
            SEAM(pb + 8);
        } else {
            if (IN(pb + 5)) { ph_ln_router(args, YF, args.in[10] + DM_, args.in[11] + DM_, HF, XB, lds, MISC, vcu, G, wave, lane, tid); }
            SEAM(pb + 5);
            if (IN(pb + 6)) { ph_gather(args, vcu, G, wave, lane); }
            SEAM(pb + 6);
            if (IN(pb + 7)) {
                unsigned cnt[8]; load_cnt(ws, cnt);
                pg8::MoeOrder S; S.init(cnt, 2 * FFE / 256, G, (int)blockIdx.x);
                pg8::Gemm g{(const bf16*)(ws + WS_XS), (const bf16*)(ws + WS_WGU_E), DM_, DM_, DM_};
                pg8::EpiSwiglu E{(bf16*)(ws + WS_ACT_E), FFE};
                pg8::gemm_phase<pg8::EpiSwiglu, pg8::MoeOrder, true>(lds + RING_OFF, g, S, E);
            }
            SEAM(pb + 7);
            if (IN(pb + 8)) {
                unsigned cnt[8]; load_cnt(ws, cnt);
                pg8::MoeOrder S; S.init(cnt, DM_ / 256, G, (int)blockIdx.x);
                pg8::Gemm g{(const bf16*)(ws + WS_ACT_E), (const bf16*)(ws + WS_WD_E), FFE, FFE, FFE};
                pg8::EpiMoeDown E{(const int*)(ws + WS_ROWMAP), (const float*)(ws + WS_ROWW), (float*)(ws + WS_Y2)};
                pg8::gemm_phase<pg8::EpiMoeDown, pg8::MoeOrder, true>(lds + RING_OFF, g, S, E);
            }
            SEAM(pb + 8);
            if (IN(pb + 9)) { ph_ln<2>(HF, (const float*)(ws + WS_Y2), args.in[19] + DM_, args.in[20] + DM_, args.out, nullptr, vcu, G, wave, lane); }
        }

    }
}
__global__ void __launch_bounds__(NWAVES * 64, 2) fwd_kernel(Args args) {
    extern __shared__ __attribute__((aligned(16))) unsigned char lds_raw[];
    LAS unsigned char* lds = (LAS unsigned char*)lds_raw;
    volatile LAS unsigned* MISC = (volatile LAS unsigned*)(lds + MISC_OFF);
    const int tid = threadIdx.x, lane = tid & 63, wave = __builtin_amdgcn_readfirstlane(tid >> 6);
    const int G = gridDim.x; const int bx = blockIdx.x; const int vcu = (G % 8 == 0) ? (bx % 8) * (G / 8) + bx / 8 : bx;
    unsigned char* ws = args.ws;
    gu32* ctl = (gu32*)(ws + WS_CTL);
    for (int u = tid; u < (LDS_BYTES - LDSCTL_OFF) / 4; u += NWAVES * 64) ((LAS unsigned*)(lds + LDSCTL_OFF))[u] = 0u;
    __syncthreads();
    XcdBarrier bar; bar.bar = (unsigned*)(ctl + CW_BAR); bar.x = 0; bar.st = nullptr;
    if (N_LAUNCHES == 1) bar = xcd_barrier_post((unsigned*)(ctl + CW_BAR), MISC + 8);
    const int lo = args.ph_lo, hi = args.ph_hi;

    bf16* const WIN = (bf16*)(ws + WS_WIN); bf16* const WBA = (bf16*)(ws + WS_WBA); bf16* const WBP = (bf16*)(ws + WS_WBP); bf16* const WBPF = (bf16*)(ws + WS_WBPF);
    bf16* const WOUT = (bf16*)(ws + WS_WOUT); bf16* const POOLB = (bf16*)(ws + WS_POOLB);
    bf16* const QKV = (bf16*)(ws + WS_QKV); bf16* const XB = (bf16*)(ws + WS_XB); float* const HF = (float*)(ws + WS_H); float* const YF = (float*)(ws + WS_Y);
    float* const MG = (float*)(ws + WS_MG); bf16* const MERGED = (bf16*)(ws + WS_MERGED); bf16* const AO = (bf16*)(ws + WS_AO); bf16* const ZB = (bf16*)(ws + WS_ZB);

    if (IN(0)) { ph_prologue(args, lds, vcu, G, wave, lane, tid); }
    SEAM(0);
    if (IN(1)) {
        pg8::Gemm g{WBP, POOLB, 1024, 256, 256}; pg8::FoldOrder S{(int)blockIdx.x}; pg8::EpiBf16Plain E{WBPF, 1024};
        pg8::gemm_phase<pg8::EpiBf16Plain, pg8::FoldOrder, false>(lds + RING_OFF, g, S, E);
    }
    SEAM(1);

    layer_phases<0>(args, lds, lds_raw, MISC, bar, lo, hi, vcu, G, wave, lane, tid);
    layer_phases<1>(args, lds, lds_raw, MISC, bar, lo, hi, vcu, G, wave, lane, tid);
#undef IN
#undef SEAM
}

extern "C" void kernel_launch(void* const* d_in, const int* in_sizes, int n_in, void* d_out, int out_size, void* d_ws, size_t ws_size, hipStream_t stream) {
    static int grid = 0;
    if (grid == 0) {
        if (n_in != 21 || in_sizes[0] != TOK * DM_ || out_size != TOK * DM_ || ws_size < WS_END) { fprintf(stderr, "kernel_launch: unexpected shapes / workspace (n_in %d, ws %zu < %zu); nothing launched\n", n_in, ws_size, (size_t)WS_END); grid = -1; return; }
        int dev = 0, cus = 0, per_cu = 0;
        if (hipGetDevice(&dev) != hipSuccess || hipDeviceGetAttribute(&cus, hipDeviceAttributeMultiprocessorCount, dev) != hipSuccess) { grid = -1; return; }
        if (hipFuncSetAttribute((const void*)fwd_kernel, hipFuncAttributeMaxDynamicSharedMemorySize, LDS_BYTES) != hipSuccess) { fprintf(stderr, "kernel_launch: hipFuncSetAttribute failed\n"); grid = -1; return; }
        if (hipOccupancyMaxActiveBlocksPerMultiprocessor(&per_cu, (const void*)fwd_kernel, NWAVES * 64, LDS_BYTES) != hipSuccess || per_cu < 1)
            fprintf(stderr, "kernel_launch: note: occupancy query reports %d workgroups per CU\n", per_cu);
        (void)hipGetLastError();
        grid = cus;
    }
    if (grid < 0) return;
    if (hipMemsetAsync((char*)d_ws + WS_CTL, 0, CTL_ZERO_BYTES, stream) != hipSuccess) return;
    Args a{};
    for (int i = 0; i < 21; ++i) a.in[i] = (const float*)d_in[i];
    a.out = (float*)d_out; a.ws = (unsigned char*)d_ws;
    for (int li = 0; li < N_LAUNCHES; ++li) {
        a.ph_lo = (N_LAUNCHES == 1) ? 0 : li; a.ph_hi = (N_LAUNCHES == 1) ? NPHASE : li + 1;
        hipLaunchKernelGGL(fwd_kernel, dim3(grid), dim3(NWAVES * 64), LDS_BYTES, stream, a);
        const hipError_t le = hipPeekAtLastError();
        if (le != hipSuccess) { fprintf(stderr, "kernel_launch: launch %d failed: %s\n", li, hipGetErrorName(le)); break; }
    }
}
```

```cpp
#include <hip/hip_runtime.h>
#include <hip/hip_bf16.h>
#include <cstdio>
#include <cstdint>
#include <cmath>

constexpr int BATCH = 2, SEQ = 8192, TOK = BATCH * SEQ, DM_ = 2048;
constexpr int AW = 1024, PW = 1024, INW = 8192;
constexpr int FFD = 5632, NEXP = 8, FFE = 7168;
constexpr float LN_EPS = 1e-5f;
constexpr float ALPHA = 1.41421356237309515f;

struct Args { const float* in[21]; float* out; unsigned char* ws; int ph_lo, ph_hi; };
#define KAS __attribute__((address_space(4)))
typedef const KAS unsigned char* kargp_t;
__device__ __forceinline__ kargp_t karg() { kargp_t p = (kargp_t)__builtin_amdgcn_kernarg_segment_ptr(); asm volatile("" : "+s"(p)); return p; }
__device__ __forceinline__ const float* arg_in(int k) { return *(const float* const KAS*)(karg() + 8 * k); }
__device__ __forceinline__ float* arg_out() { return *(float* const KAS*)(karg() + 8 * 21); }
__device__ __forceinline__ unsigned char* arg_ws() { return *(unsigned char* const KAS*)(karg() + 8 * 22); }
static_assert(sizeof(Args) == 192, "Args layout");

namespace pg8 {
#define PG8_LAS __attribute__((address_space(3)))
typedef unsigned short bf16_t;
typedef short bf16x8 __attribute__((ext_vector_type(8)));
typedef float f32x4 __attribute__((ext_vector_type(4)));
typedef unsigned u32x4 __attribute__((ext_vector_type(4)));
typedef unsigned u32x2 __attribute__((ext_vector_type(2)));
constexpr int BM = 256, BK = 64, HALF = 128, HTB = HALF * BK * 2  , STAGE_BYTES = 8 * HTB, NXCD = 8, WGM = 8;

__host__ __device__ __forceinline__ int lds_byte(int r, int c) { const int st = (r >> 4) * 2 + (c >> 5), rr = r & 15, cc = c & 31, ob = rr * 64 + cc * 2; return st * 1024 + (ob ^ (((ob >> 9) & 1) << 5)); }
__host__ __device__ __forceinline__ void stage_rc(int b, int& R, int& C) { const int st = b / 1024, sb = b % 1024, swz = sb ^ (((sb >> 9) & 1) << 5); R = (st >> 1) * 16 + swz / 64; C = (st & 1) * 32 + (swz % 64) / 2; }
__host__ __device__ __forceinline__ int perm32(int rho) { const int n = rho >> 4, i = rho & 15; return 8 * (i >> 2) + 4 * n + (i & 3); }

struct Unit { int pm, pn, pb, ka; };
struct Gemm { const bf16_t* A; const bf16_t* Bt; int lda, ldb, K; };

struct StaticOrder {
    int nM, nN, nwg, G, c;
    __host__ __device__ void init(int M, int N, int G_, int c_) { nM = M / BM; nN = N / BM; nwg = nM * nN; G = G_; c = c_; }
    __host__ __device__ bool next(int i, Unit& u) const {
        const long L = (long)i * G + c; if (L >= nwg) return false;
        int wgid = (int)L; { const int q = nwg / NXCD, r = nwg % NXCD, xcd = wgid % NXCD, off = wgid / NXCD; wgid = (xcd < r ? xcd * (q + 1) : r * (q + 1) + (xcd - r) * q) + off; }
        const int nig = WGM * nN, gid = wgid / nig, fm = gid * WGM, gsz = (nM - fm) < WGM ? (nM - fm) : WGM;
        u.pm = fm + ((wgid % nig) % gsz); u.pn = (wgid % nig) / gsz; u.pb = u.pn; u.ka = 0; return true;
    }
    __device__ __forceinline__ void a_ready(const Unit&) const {}
    __device__ __forceinline__ void done(const Unit&) const {}
};
struct FoldOrder {
    int c;
    __device__ bool next(int i, Unit& u) const {
        if (i > 0 || c >= 64) return false;
        const int l = c >> 5, g = (c >> 3) & 3, pm = c & 7;
        u.pm = l * 8 + pm; u.pn = g; u.pb = l * 4 + g; u.ka = 256 * g; return true;
    }
    __device__ __forceinline__ void a_ready(const Unit&) const {}
    __device__ __forceinline__ void done(const Unit&) const {}
};
struct MoeOrder {
    int nN, G, c, nwg;
    int n0, n1, n2, n3, n4, n5, n6, n7;
    __device__ __forceinline__ void init(const unsigned (&cnt)[8], int nN_, int G_, int c_) {
        nN = nN_; G = G_; c = c_;
        n0 = (int)((cnt[0] + 255u) >> 8); n1 = (int)((cnt[1] + 255u) >> 8); n2 = (int)((cnt[2] + 255u) >> 8); n3 = (int)((cnt[3] + 255u) >> 8);
        n4 = (int)((cnt[4] + 255u) >> 8); n5 = (int)((cnt[5] + 255u) >> 8); n6 = (int)((cnt[6] + 255u) >> 8); n7 = (int)((cnt[7] + 255u) >> 8);
        nwg = (n0 + n1 + n2 + n3 + n4 + n5 + n6 + n7) * nN_;
    }
    __device__ __forceinline__ bool next(int i, Unit& u) const {
        const long L = (long)i * G + c; if (L >= nwg) return false;
        int wgid = (int)L; { const int q = nwg / NXCD, r = nwg % NXCD, xcd = wgid % NXCD, off = wgid / NXCD; wgid = (xcd < r ? xcd * (q + 1) : r * (q + 1) + (xcd - r) * q) + off; }
        int e = 0, nte = n0, to = 0, pt = n0;
#define MOE_STEP(k, nk) do { if (wgid >= pt * nN) { e = (k); nte = (nk); to = pt; } pt += (nk); } while (0)
        MOE_STEP(1, n1); MOE_STEP(2, n2); MOE_STEP(3, n3); MOE_STEP(4, n4); MOE_STEP(5, n5); MOE_STEP(6, n6); MOE_STEP(7, n7);
#undef MOE_STEP
        const int rem = wgid - to * nN, nig = WGM * nN, gid = rem / nig, fm = gid * WGM, gsz = (nte - fm) < WGM ? (nte - fm) : WGM;
        const int w = rem % nig;
        u.pm = to + fm + (w % gsz); u.pn = w / gsz; u.pb = e * nN + u.pn; u.ka = 0; return true;
    }
    __device__ __forceinline__ void a_ready(const Unit&) const {}
    __device__ __forceinline__ void done(const Unit&) const {}
};

__device__ __forceinline__ unsigned cvt_pk_bf16(float lo, float hi) { unsigned r; asm volatile("v_cvt_pk_bf16_f32 %0, %1, %2" : "=v"(r) : "v"(lo), "v"(hi)); return r; }
__device__ __forceinline__ float sigm(float x) { return __builtin_amdgcn_rcpf(1.0f + __builtin_amdgcn_exp2f(-1.4426950408889634f * x)); }
__device__ __forceinline__ float bflo(unsigned w) { return __uint_as_float(w << 16); }
__device__ __forceinline__ float bfhi(unsigned w) { return __uint_as_float(w & 0xffff0000u); }
__device__ __forceinline__ u32x4 pack8(const f32x4 v0, const f32x4 v1) { u32x4 w; w.x = cvt_pk_bf16(v0[0], v0[1]); w.y = cvt_pk_bf16(v0[2], v0[3]); w.z = cvt_pk_bf16(v1[0], v1[1]); w.w = cvt_pk_bf16(v1[2], v1[3]); return w; }

struct EpiInProj {
    static constexpr bool PERM = true, AFTER_DRAIN = false;
    bf16_t* O; float scale0; int tbase, tskip; float s;
    __device__ __forceinline__ void operator()(const f32x4 (&acc)[2][2][4][2], const Unit& u, int wr, int wc, int fr, int fq) const {
        const int row0 = u.pm * BM + wr * 64 + fr; const int ct = u.pn * BM; int t = tbase + (ct >> 10); if (t >= tskip) t += 1;
        const float s0 = (t == 0) ? s * scale0 : s;
        bf16_t* base = O + (size_t)t * ((size_t)TOK * 1024);
        const int col0 = (ct & 1023) + wc * 32 + 8 * fq;
#pragma unroll
        for (int ai = 0; ai < 2; ++ai)
#pragma unroll
            for (int m = 0; m < 4; ++m) { bf16_t* rowp = base + (size_t)(row0 + ai * HALF + m * 16) * 1024 + col0;
#pragma unroll
                for (int bj = 0; bj < 2; ++bj) { f32x4 v0 = acc[ai][bj][m][0], v1 = acc[ai][bj][m][1];
                    v0 = v0 * s0; v1 = v1 * s0;
                    if (t >= 4) {
#pragma unroll
                        for (int k = 0; k < 4; ++k) { v0[k] = sigm(v0[k]); v1[k] = sigm(v1[k]); } }
                    *(u32x4*)(rowp + bj * HALF) = pack8(v0, v1); } }
    }
};
struct EpiBf16Plain {
    static constexpr bool PERM = true, AFTER_DRAIN = false;
    bf16_t* O; int ldc;
    __device__ __forceinline__ void operator()(const f32x4 (&acc)[2][2][4][2], const Unit& u, int wr, int wc, int fr, int fq) const {
        const int row0 = u.pm * BM + wr * 64 + fr; const int col0 = u.pn * BM + wc * 32 + 8 * fq;
#pragma unroll
        for (int ai = 0; ai < 2; ++ai)
#pragma unroll
            for (int m = 0; m < 4; ++m) { bf16_t* rowp = O + (size_t)(row0 + ai * HALF + m * 16) * ldc + col0;
#pragma unroll
                for (int bj = 0; bj < 2; ++bj) *(u32x4*)(rowp + bj * HALF) = pack8(acc[ai][bj][m][0], acc[ai][bj][m][1]); }
    }
};
struct HookGateRatio {
    static constexpr bool ENABLED = true;
    const bf16_t* Ga; const bf16_t* Gp;
    __device__ __forceinline__ void operator()(f32x4 (&acc)[2][2][4][2], const Unit& u, int wr, int wc, int fr, int fq) const {
        const int row0 = u.pm * BM + wr * 64 + fr; const int ct = u.pn * BM;
        const size_t go = (size_t)(ct >> 10) * ((size_t)TOK * 1024) + (ct & 1023) + wc * 32 + 8 * fq;
#pragma unroll
        for (int ai = 0; ai < 2; ++ai) {
            u32x4 a[4][2], p[4][2];
#pragma unroll
            for (int m = 0; m < 4; ++m)
#pragma unroll
                for (int bj = 0; bj < 2; ++bj) { const size_t o = go + (size_t)(row0 + ai * HALF + m * 16) * 1024 + bj * HALF; a[m][bj] = *(const u32x4*)(Ga + o); p[m][bj] = *(const u32x4*)(Gp + o); }
#pragma unroll
            for (int m = 0; m < 4; ++m)
#pragma unroll
                for (int bj = 0; bj < 2; ++bj) { const u32x4 x = a[m][bj], y = p[m][bj];
                    const f32x4 r0 = {bflo(x.x) * __builtin_amdgcn_rcpf(bflo(y.x)), bfhi(x.x) * __builtin_amdgcn_rcpf(bfhi(y.x)), bflo(x.y) * __builtin_amdgcn_rcpf(bflo(y.y)), bfhi(x.y) * __builtin_amdgcn_rcpf(bfhi(y.y))};
                    const f32x4 r1 = {bflo(x.z) * __builtin_amdgcn_rcpf(bflo(y.z)), bfhi(x.z) * __builtin_amdgcn_rcpf(bfhi(y.z)), bflo(x.w) * __builtin_amdgcn_rcpf(bflo(y.w)), bfhi(x.w) * __builtin_amdgcn_rcpf(bfhi(y.w))};
                    acc[ai][bj][m][0] = acc[ai][bj][m][0] * r0; acc[ai][bj][m][1] = acc[ai][bj][m][1] * r1; }
            asm volatile("" ::: "memory");
        }
    }
};
struct NoHook { static constexpr bool ENABLED = false; __device__ __forceinline__ void operator()(f32x4 (&)[2][2][4][2], const Unit&, int, int, int, int) const {} };
struct EpiGateFinal {
    static constexpr bool PERM = true, AFTER_DRAIN = false;
    const bf16_t* Gp; bf16_t* Out;
    __device__ __forceinline__ void operator()(const f32x4 (&acc)[2][2][4][2], const Unit& u, int wr, int wc, int fr, int fq) const {
        const int row0 = u.pm * BM + wr * 64 + fr; const int ct = u.pn * BM;
        const bf16_t* gb = Gp + (size_t)(ct >> 10) * ((size_t)TOK * 1024) + (ct & 1023) + wc * 32 + 8 * fq;
        const int col0 = ct + wc * 32 + 8 * fq;
#pragma unroll
        for (int ai = 0; ai < 2; ++ai)
#pragma unroll
            for (int m = 0; m < 4; ++m) { const int r = row0 + ai * HALF + m * 16;
#pragma unroll
                for (int bj = 0; bj < 2; ++bj) { const u32x4 g = *(const u32x4*)(gb + (size_t)r * 1024 + bj * HALF);
                    const f32x4 g0 = {bflo(g.x), bfhi(g.x), bflo(g.y), bfhi(g.y)}, g1 = {bflo(g.z), bfhi(g.z), bflo(g.w), bfhi(g.w)};
                    *(u32x4*)(Out + (size_t)r * DM_ + col0 + bj * HALF) = pack8(acc[ai][bj][m][0] * g0, acc[ai][bj][m][1] * g1); } }
    }
};
struct EpiRes {
    static constexpr bool PERM = true, AFTER_DRAIN = false;
    const bf16_t* base; bf16_t* out; float alpha;
    __device__ __forceinline__ void operator()(const f32x4 (&acc)[2][2][4][2], const Unit& u, int wr, int wc, int fr, int fq) const {
        const int row0 = u.pm * BM + wr * 64 + fr; const int col0 = u.pn * BM + wc * 32 + 8 * fq;
#pragma unroll
        for (int ai = 0; ai < 2; ++ai)
#pragma unroll
            for (int m = 0; m < 4; ++m) { const size_t ro = (size_t)(row0 + ai * HALF + m * 16) * DM_ + col0;
#pragma unroll
                for (int bj = 0; bj < 2; ++bj) { const u32x4 b = *(const u32x4*)(base + ro + bj * HALF);
                    const f32x4 b0 = {bflo(b.x), bfhi(b.x), bflo(b.y), bfhi(b.y)}, b1 = {bflo(b.z), bfhi(b.z), bflo(b.w), bfhi(b.w)};
                    *(u32x4*)(out + ro + bj * HALF) = pack8(b0 * alpha + acc[ai][bj][m][0], b1 * alpha + acc[ai][bj][m][1]); } }
    }
};
struct EpiResLn {
    static constexpr bool PERM = true, AFTER_DRAIN = false;
    bf16_t* Y; const float* st; const float* gp; const float* bp; float alpha; float s;
    __device__ __forceinline__ void operator()(const f32x4 (&acc)[2][2][4][2], const Unit& u, int wr, int wc, int fr, int fq) const {
        const int row0 = u.pm * BM + wr * 64 + fr; const int col0 = u.pn * BM + wc * 32 + 8 * fq;
        f32x4 gv[2][2], bv[2][2];
#pragma unroll
        for (int bj = 0; bj < 2; ++bj)
#pragma unroll
            for (int n = 0; n < 2; ++n) { gv[bj][n] = *(const f32x4*)(gp + col0 + bj * HALF + n * 4); bv[bj][n] = *(const f32x4*)(bp + col0 + bj * HALF + n * 4); }
#pragma unroll
        for (int ai = 0; ai < 2; ++ai)
#pragma unroll
            for (int m = 0; m < 4; ++m) { const int r = row0 + ai * HALF + m * 16; const float mu = st[2 * r], rs = st[2 * r + 1]; bf16_t* yr = Y + (size_t)r * DM_ + col0;
#pragma unroll
                for (int bj = 0; bj < 2; ++bj) { const u32x4 y = *(const u32x4*)(yr + bj * HALF);
                    const f32x4 y0 = {bflo(y.x), bfhi(y.x), bflo(y.y), bfhi(y.y)}, y1 = {bflo(y.z), bfhi(y.z), bflo(y.w), bfhi(y.w)};
                    const f32x4 h0 = (y0 - mu) * rs * gv[bj][0] + bv[bj][0], h1 = (y1 - mu) * rs * gv[bj][1] + bv[bj][1];
                    *(u32x4*)(yr + bj * HALF) = pack8(h0 * alpha + acc[ai][bj][m][0] * s, h1 * alpha + acc[ai][bj][m][1] * s); } }
    }
};
struct EpiSwiglu {
    static constexpr bool PERM = true, AFTER_DRAIN = false;
    bf16_t* O; int ldo; float s;
    __device__ __forceinline__ void operator()(const f32x4 (&acc)[2][2][4][2], const Unit& u, int wr, int wc, int fr, int fq) const {
        const int row0 = u.pm * BM + wr * 64 + fr; const int col0 = u.pn * HALF + wc * 32 + 8 * fq;
#pragma unroll
        for (int ai = 0; ai < 2; ++ai)
#pragma unroll
            for (int m = 0; m < 4; ++m) { f32x4 h0, h1;
#pragma unroll
                for (int k = 0; k < 4; ++k) { const float g0 = acc[ai][0][m][0][k] * s, g1 = acc[ai][0][m][1][k] * s;
                    h0[k] = g0 * sigm(g0) * (acc[ai][1][m][0][k] * s); h1[k] = g1 * sigm(g1) * (acc[ai][1][m][1][k] * s); }
                *(u32x4*)(O + (size_t)(row0 + ai * HALF + m * 16) * ldo + col0) = pack8(h0, h1); }
    }
};
__device__ __forceinline__ unsigned pk4_fp8(float a, float b, float c, float d) { int w = __builtin_amdgcn_cvt_pk_fp8_f32(a, b, 0, false); w = __builtin_amdgcn_cvt_pk_fp8_f32(c, d, w, true); return (unsigned)w; }
__device__ __forceinline__ float clamp448(float x) { return __builtin_fminf(__builtin_fmaxf(x, -448.0f), 448.0f); }
constexpr float ACT8_SCALE = 4.0f;
struct EpiSwiglu8 {
    static constexpr bool PERM = true, AFTER_DRAIN = false;
    unsigned char* Ob; int ldo; float s;
    __device__ __forceinline__ void operator()(const f32x4 (&acc)[2][2][4][2], const Unit& u, int wr, int wc, int fr, int fq) const {
        unsigned char* const O = Ob + (size_t)u.pm * BM * ldo + u.pn * HALF;
        const unsigned off0 = (unsigned)((wr * 64 + fr) * ldo + wc * 32 + 8 * fq); const float su = s * ACT8_SCALE;
#pragma unroll
        for (int ai = 0; ai < 2; ++ai)
#pragma unroll
            for (int m = 0; m < 4; ++m) { f32x4 h0, h1;
#pragma unroll
                for (int k = 0; k < 4; ++k) { const float g0 = acc[ai][0][m][0][k] * s, g1 = acc[ai][0][m][1][k] * s;
                    h0[k] = clamp448(g0 * sigm(g0) * (acc[ai][1][m][0][k] * su)); h1[k] = clamp448(g1 * sigm(g1) * (acc[ai][1][m][1][k] * su)); }
                u32x2 w; w.x = pk4_fp8(h0[0], h0[1], h0[2], h0[3]); w.y = pk4_fp8(h1[0], h1[1], h1[2], h1[3]);
                *(u32x2*)(O + (off0 + (unsigned)((ai * HALF + m * 16) * ldo))) = w; }
    }
};
struct EpiMoeDown {
    static constexpr bool PERM = true, AFTER_DRAIN = false;
    const int* rowmap; const float* roww; bf16_t* Y2; float s;
    __device__ __forceinline__ void operator()(const f32x4 (&acc)[2][2][4][2], const Unit& u, int wr, int wc, int fr, int fq) const {
        const int row0 = u.pm * BM + wr * 64 + fr; const int col0 = u.pn * BM + wc * 32 + 8 * fq;
#pragma unroll
        for (int ai = 0; ai < 2; ++ai)
#pragma unroll
            for (int m = 0; m < 4; ++m) { const int r = row0 + ai * HALF + m * 16; const int tm = rowmap[r];
                if (tm >= 0) { const float w = roww[r] * s; bf16_t* o = Y2 + (size_t)tm * DM_ + col0;
#pragma unroll
                    for (int bj = 0; bj < 2; ++bj) *(u32x4*)(o + bj * HALF) = pack8(acc[ai][bj][m][0] * w, acc[ai][bj][m][1] * w); } }
    }
};

__device__ __forceinline__ void glds16s(const char* sbase, unsigned voff, unsigned lds_dst) { unsigned keep;
    asm volatile("s_mov_b32 %0, m0\n\ts_mov_b32 m0, %3\n\ts_nop 0\n\tglobal_load_lds_dwordx4 %1, %2\n\ts_mov_b32 m0, %0" : "=&s"(keep) : "v"(voff), "s"(sbase), "s"(lds_dst) : "memory"); }
typedef int v8i_t __attribute__((ext_vector_type(8)));
typedef int v4i_t __attribute__((ext_vector_type(4)));
__device__ __forceinline__ v8i_t cat8(bf16x8 a, bf16x8 b) { const v4i_t x = __builtin_bit_cast(v4i_t, a), y = __builtin_bit_cast(v4i_t, b); return __builtin_shufflevector(x, y, 0, 1, 2, 3, 4, 5, 6, 7); }
template <class Epi, class Sched, bool ALIGN_EPI = false, bool F8 = false, class Hook = NoHook>
__device__ __forceinline__ void gemm_phase(PG8_LAS unsigned char* lds, const Gemm g, const Sched& S, const Epi& E, const Hook& H = Hook()) {
    int tid_ = threadIdx.x; asm volatile("" : "+v"(tid_));
    const int tid = tid_, wid = __builtin_amdgcn_readfirstlane(tid >> 6), lane = tid & 63, wr = wid >> 2, wc = wid & 3, fr = lane & 15, fq = lane >> 4;
    const int K = g.K, nt = K / BK;
    unsigned voffA[2], voffB[2];
#pragma unroll
    for (int i = 0; i < 2; ++i) { int R, C; stage_rc(tid * 16 + i * 8192, R, C); const int Rb = Epi::PERM ? ((R & ~31) + perm32(R & 31)) : R;
        voffA[i] = (unsigned)(R * g.lda + C) * 2u; voffB[i] = (unsigned)(Rb * g.ldb + C) * 2u; }
    const size_t kstep = (size_t)(BK * 2);
    const size_t hstepA = (size_t)HALF * g.lda * 2, hstepB = (size_t)HALF * g.ldb * 2;
    const unsigned ldsb = (unsigned)__builtin_amdgcn_readfirstlane((int)((unsigned)(size_t)lds + (unsigned)wid * 1024u));
    unsigned a_addr = (unsigned)(size_t)lds + (unsigned)lds_byte(wr * 64 + fr, fq * 8), b_addr = (unsigned)(size_t)lds + (unsigned)(4 * HTB + lds_byte(wc * 32 + fr, fq * 8)); asm volatile("" : "+v"(a_addr), "+v"(b_addr));
#define PG8_SA(b, h) (((b) * 2 + (h)) * HTB)
#define PG8_SB(b, h) ((4 + (b) * 2 + (h)) * HTB)
#define PG8_STAGE(bufoff, gbase, voff) do { _Pragma("unroll") for (int _i = 0; _i < 2; ++_i) glds16s((const char*)(gbase), (voff)[_i], ldsb + (unsigned)((bufoff) + _i * 8192)); } while (0)
#define PG8_LDA(dst, b, h) do { _Pragma("unroll") for (int m = 0; m < 4; ++m) _Pragma("unroll") for (int k = 0; k < 2; ++k) dst[m][k] = *(const PG8_LAS bf16x8*)(size_t)(a_addr + (unsigned)(PG8_SA(b, h) + m * 2048 + k * 1024)); } while (0)
#define PG8_LDB(dst, b, h) do { _Pragma("unroll") for (int n = 0; n < 2; ++n) _Pragma("unroll") for (int k = 0; k < 2; ++k) dst[n][k] = *(const PG8_LAS bf16x8*)(size_t)(b_addr + (unsigned)(PG8_SB(b, h) - 4 * HTB + n * 2048 + k * 1024)); } while (0)
#define PG8_MMA(ai, bj, At, Bt) do { __builtin_amdgcn_s_setprio(1); _Pragma("unroll") for (int m = 0; m < 4; ++m) _Pragma("unroll") for (int n = 0; n < 2; ++n) { \
        if constexpr (F8) acc[ai][bj][m][n] = __builtin_amdgcn_mfma_scale_f32_16x16x128_f8f6f4(cat8(Bt[n][0], Bt[n][1]), cat8(At[m][0], At[m][1]), acc[ai][bj][m][n], 0, 0, 0, 0, 0, 0);     \
        else { _Pragma("unroll") for (int k = 0; k < 2; ++k) acc[ai][bj][m][n] = __builtin_amdgcn_mfma_f32_16x16x32_bf16(Bt[n][k], At[m][k], acc[ai][bj][m][n], 0, 0, 0); } } \
        __builtin_amdgcn_s_setprio(0); } while (0)
#define PG8_WAIT_V(n) asm volatile("s_waitcnt vmcnt(" #n ")" ::: "memory")
#define PG8_WAIT_L(n) asm volatile("s_waitcnt lgkmcnt(" #n ")" ::: "memory")
#define PG8_BAR __builtin_amdgcn_s_barrier()
#define PG8_SCHED __builtin_amdgcn_sched_barrier(0)
    Unit cur, nxt; int ui = 0;
    if (!S.next(0, cur)) return;
    f32x4 acc[2][2][4][2];
#pragma unroll
    for (int a = 0; a < 2; ++a)
#pragma unroll
        for (int b = 0; b < 2; ++b)
#pragma unroll
            for (int m = 0; m < 4; ++m)
#pragma unroll
                for (int n = 0; n < 2; ++n) acc[a][b][m][n] = (f32x4){0.f, 0.f, 0.f, 0.f};
    bf16x8 At[4][2], B0[2][2], B1[2][2];
    const char* cA = (const char*)g.A + (size_t)cur.pm * 2 * hstepA + (size_t)cur.ka * 2; const char* cB = (const char*)g.Bt + (size_t)cur.pb * 2 * hstepB;
    S.a_ready(cur);
    PG8_STAGE(PG8_SB(0, 0), cB, voffB); PG8_STAGE(PG8_SB(0, 1), cB + hstepB, voffB); PG8_STAGE(PG8_SA(0, 0), cA, voffA); PG8_STAGE(PG8_SA(0, 1), cA + hstepA, voffA);
    if (wr == 1) PG8_BAR;
    PG8_WAIT_V(2); PG8_BAR;
    PG8_STAGE(PG8_SB(1, 0), cB + kstep, voffB); PG8_STAGE(PG8_SA(1, 0), cA + kstep, voffA); PG8_STAGE(PG8_SB(1, 1), cB + hstepB + kstep, voffB);
    PG8_WAIT_V(6); PG8_BAR;
    for (;;) {
        const bool has_next = S.next(ui + 1, nxt);
        const char* nA = has_next ? (const char*)g.A + (size_t)nxt.pm * 2 * hstepA + (size_t)nxt.ka * 2 : cA; const char* nB = has_next ? (const char*)g.Bt + (size_t)nxt.pb * 2 * hstepB : cB;
        for (int t = 0; t < nt; t += 2) {
            const bool last = (t == nt - 2);
            const char* a1 = cA + (size_t)(t + 1) * kstep;
            const char* a2 = last ? nA : cA + (size_t)(t + 2) * kstep; const char* b2 = last ? nB : cB + (size_t)(t + 2) * kstep;
            const char* a3 = a2 + kstep; const char* b3 = b2 + kstep;
            if (last && has_next) S.a_ready(nxt);
            if constexpr (Hook::ENABLED) { if (t == nt / 2) {
                int t3 = threadIdx.x; asm volatile("" : "+v"(t3)); const int w3 = __builtin_amdgcn_readfirstlane(t3 >> 6), l3 = t3 & 63; H(acc, cur, w3 >> 2, w3 & 3, l3 & 15, l3 >> 4); } }
            PG8_LDB(B0, 0, 0); PG8_LDB(B1, 0, 1); PG8_SCHED; PG8_LDA(At, 0, 0); PG8_STAGE(PG8_SA(1, 1), a1 + hstepA, voffA);
            PG8_WAIT_V(8); PG8_WAIT_L(0); PG8_BAR; PG8_MMA(0, 0, At, B0); PG8_MMA(0, 1, At, B1); PG8_BAR; PG8_SCHED;
            PG8_LDA(At, 0, 1); PG8_STAGE(PG8_SB(0, 0), b2, voffB); PG8_STAGE(PG8_SB(0, 1), b2 + hstepB, voffB); PG8_STAGE(PG8_SA(0, 0), a2, voffA);
            PG8_WAIT_V(8); PG8_WAIT_L(0); PG8_BAR; PG8_MMA(1, 0, At, B0); PG8_MMA(1, 1, At, B1); PG8_BAR; PG8_SCHED;
            PG8_LDB(B0, 1, 0); PG8_LDB(B1, 1, 1); PG8_SCHED; PG8_LDA(At, 1, 0); PG8_STAGE(PG8_SA(0, 1), a2 + hstepA, voffA);
            PG8_WAIT_V(8); PG8_WAIT_L(0); PG8_BAR; PG8_MMA(0, 0, At, B0); PG8_MMA(0, 1, At, B1); PG8_BAR; PG8_SCHED;
            PG8_LDA(At, 1, 1); PG8_STAGE(PG8_SB(1, 0), b3, voffB); PG8_STAGE(PG8_SB(1, 1), b3 + hstepB, voffB); PG8_STAGE(PG8_SA(1, 0), a3, voffA);
            PG8_WAIT_V(8); PG8_WAIT_L(0); PG8_BAR; PG8_MMA(1, 0, At, B0); PG8_MMA(1, 1, At, B1); PG8_BAR; PG8_SCHED;
        }
        if constexpr (ALIGN_EPI) { if (wr == 0) PG8_BAR; }
        { int t2 = threadIdx.x; asm volatile("" : "+v"(t2));
          const int w2 = __builtin_amdgcn_readfirstlane(t2 >> 6), l2 = t2 & 63; E(acc, cur, w2 >> 2, w2 & 3, l2 & 15, l2 >> 4); } S.done(cur);
        if (!has_next) break;
#pragma unroll
        for (int a = 0; a < 2; ++a)
#pragma unroll
            for (int b = 0; b < 2; ++b)
#pragma unroll
                for (int m = 0; m < 4; ++m)
#pragma unroll
                    for (int n = 0; n < 2; ++n) acc[a][b][m][n] = (f32x4){0.f, 0.f, 0.f, 0.f};
        cur = nxt; cA = nA; cB = nB; ++ui;
        if constexpr (ALIGN_EPI) { if (wr == 1) PG8_BAR; }
    }
    PG8_WAIT_V(0);
    if constexpr (!ALIGN_EPI) { if (wr == 0) PG8_BAR; }
    PG8_BAR;
#undef PG8_SA
#undef PG8_SB
#undef PG8_STAGE
#undef PG8_LDA
#undef PG8_LDB
#undef PG8_MMA
#undef PG8_WAIT_V
#undef PG8_WAIT_L
#undef PG8_BAR
#undef PG8_SCHED
}
}

namespace attn_body {
using bf16=__hip_bfloat16;
using bf16x8=__attribute__((ext_vector_type(8)))short;
using s16x4=__attribute__((ext_vector_type(4)))short;
using f32x16=__attribute__((ext_vector_type(16)))float;
using u32x4=__attribute__((ext_vector_type(4)))unsigned;
constexpr int SEQ=8192,D=64,DM=1024;
constexpr int NW=8,QBLK=32,QB=QBLK*NW,KVBLK=64,NQB=SEQ/QB;
constexpr int ATTN_PITCH=DM, ATTN_UNIT_ROWS=QB;
__device__ __forceinline__ int crow(int r,int hi){return (r&3)+8*(r>>2)+4*hi;}
#define SBAR() __builtin_amdgcn_sched_barrier(0)
typedef __attribute__((address_space(3))) const float* lds_fptr;
__device__ __forceinline__ void cmask_bias(f32x16&p0,f32x16&p1,int jb,int qrel,int hi,lds_fptr tbl){
  const float NEG=-INFINITY; const int nb=qrel-64*jb-4*hi;
  #pragma unroll
  for(int r=0;r<16;++r){const int n0=nb-((r&3)+8*(r>>2)), n1=n0-32;
    const int i0=n0<0?0:(n0>127?127:n0), i1=n1<0?0:(n1>127?127:n1);
    const float b0=tbl[i0], b1=tbl[i1];
    p0[r]=(n0<0)?NEG:(p0[r]+b0); p1[r]=(n1<0)?NEG:(p1[r]+b1);
    if((r&3)==3) asm volatile("":::"memory");}
}

constexpr int NSLOT=3, SLOTB=8192, SLOTV=16384;
constexpr int LDS_K=0, LDS_V=NSLOT*SLOTB, LDS_WS=LDS_V+NSLOT*SLOTV, LDS_OST=LDS_WS+NW*64*4, LDS_BYTES=LDS_OST+NW*4096;
constexpr float C2=0.125f*1.4426950408889634f;
__device__ __forceinline__ void glds16(const void*gsrc,unsigned lds_dst){unsigned keep;
  asm volatile("s_mov_b32 %0, m0\n\ts_mov_b32 m0, %2\n\ts_nop 0\n\tglobal_load_lds_dwordx4 %1, off\n\ts_mov_b32 m0, %0":"=&s"(keep):"v"(gsrc),"s"(lds_dst):"memory");}
__device__ __forceinline__ float max3f(float a,float b,float c){float r;asm("v_max3_f32 %0, %1, %2, %3":"=v"(r):"v"(a),"v"(b),"v"(c));return r;}
__device__ __forceinline__ float max2f(float a,float b){float r;asm("v_max_f32_e32 %0, %1, %2":"=v"(r):"v"(a),"v"(b));return r;}
typedef float f32x2_t __attribute__((ext_vector_type(2))); typedef __bf16 bf16x2_t __attribute__((ext_vector_type(2)));
__device__ __forceinline__ unsigned cvtpk_s(float lo,float hi){f32x2_t v={lo,hi};bf16x2_t b=__builtin_convertvector(v,bf16x2_t);return __builtin_bit_cast(unsigned,b);}
#define WAIT_BAR(N) asm volatile("s_waitcnt vmcnt(" #N ") lgkmcnt(0)\n\ts_barrier":::"memory")

typedef __attribute__((address_space(3))) const char* lds_cptr;
typedef short v4i16_t __attribute__((ext_vector_type(4)));
#define LDSQ(p) (*(const __attribute__((address_space(3))) bf16x8*)(p))
__device__ __forceinline__ void qkt(f32x16&p0,f32x16&p1,const char*Kslot,const bf16x8*qr,int r32,int hi){
  const char*kb=Kslot+hi*1024+r32*16; const f32x16 z=f32x16{};
  #pragma unroll
  for(int d0=0;d0<4;++d0){
    const bf16x8 b0=*reinterpret_cast<const bf16x8*>(kb+d0*2048);
    const bf16x8 b1=*reinterpret_cast<const bf16x8*>(kb+d0*2048+512);
    const bf16x8 q=qr[d0];
    if(d0==0){p0=__builtin_amdgcn_mfma_f32_32x32x16_bf16(b0,q,z,0,0,0);p1=__builtin_amdgcn_mfma_f32_32x32x16_bf16(b1,q,z,0,0,0);}
    else{p0=__builtin_amdgcn_mfma_f32_32x32x16_bf16(b0,q,p0,0,0,0);p1=__builtin_amdgcn_mfma_f32_32x32x16_bf16(b1,q,p1,0,0,0);}}
}
__device__ __forceinline__ void kload8(bf16x8*kf,lds_cptr kp){
  kf[0]=LDSQ(kp);      kf[1]=LDSQ(kp+512);  kf[2]=LDSQ(kp+2048); kf[3]=LDSQ(kp+2560);
  kf[4]=LDSQ(kp+4096); kf[5]=LDSQ(kp+4608); kf[6]=LDSQ(kp+6144); kf[7]=LDSQ(kp+6656);
}
__device__ __forceinline__ void kload2(bf16x8*kf,lds_cptr kp,int j){ kf[2*j]=LDSQ(kp+j*2048); kf[2*j+1]=LDSQ(kp+j*2048+512); }
__device__ __forceinline__ s16x4 vtr(lds_cptr p){ return __builtin_bit_cast(s16x4,__builtin_amdgcn_ds_read_tr16_b64_v4i16((__attribute__((address_space(3))) v4i16_t*)p)); }
__device__ __forceinline__ float rowmax(const f32x16&p0,const f32x16&p1){
  float a=max3f(p0[0],p0[1],p1[0]),b=max3f(p0[2],p0[3],p1[1]);a=max3f(a,p1[2],p1[3]);
  #pragma unroll
  for(int r=4;r<16;r+=4){a=max3f(a,p0[r],p0[r+1]);b=max3f(b,p0[r+2],p0[r+3]);a=max3f(a,p1[r],p1[r+1]);b=max3f(b,p1[r+2],p1[r+3]);}
  const float m=max2f(a,b);
  auto rr=__builtin_amdgcn_permlane32_swap(__float_as_uint(m),__float_as_uint(m),false,false);
  return max2f(__uint_as_float(rr[0]),__uint_as_float(rr[1]));
}
__device__ __forceinline__ void pv(f32x16*o,int vb,bf16x8 pa0,bf16x8 pa1,bf16x8 pa2,bf16x8 pa3){
  #pragma unroll
  for(int d0=0;d0<4;++d0){s16x4 lo[4],hi[4];
    #pragma unroll
    for(int ks=0;ks<4;++ks){
      asm volatile("ds_read_b64_tr_b16 %0,%1 offset:%c2":"=&v"(lo[ks]):"v"(vb),"i"(d0*4096+ks*1024):"memory");
      asm volatile("ds_read_b64_tr_b16 %0,%1 offset:%c2":"=&v"(hi[ks]):"v"(vb),"i"(d0*4096+ks*1024+512):"memory");}
    asm volatile("s_waitcnt lgkmcnt(0)":::"memory");SBAR();
    #define PK(k) (bf16x8){lo[k][0],lo[k][1],lo[k][2],lo[k][3],hi[k][0],hi[k][1],hi[k][2],hi[k][3]}
    o[d0]=__builtin_amdgcn_mfma_f32_32x32x16_bf16(pa0,PK(0),o[d0],0,0,0);
    o[d0]=__builtin_amdgcn_mfma_f32_32x32x16_bf16(pa1,PK(1),o[d0],0,0,0);
    o[d0]=__builtin_amdgcn_mfma_f32_32x32x16_bf16(pa2,PK(2),o[d0],0,0,0);
    o[d0]=__builtin_amdgcn_mfma_f32_32x32x16_bf16(pa3,PK(3),o[d0],0,0,0);
    #undef PK
  }
}

#ifndef ATTN_STORE16
#define ATTN_STORE16(p,v) (*(u32x4*)(p)=(v))
#endif
template<int THRL> __device__ __forceinline__ void attn_unit(int b,int qcol,int vcol,int qb,const bf16*Q,const bf16*__restrict__ K,const bf16*__restrict__ V,bf16*O,char*shm,lds_fptr tbl){
  int tid_=threadIdx.x; asm volatile("":"+v"(tid_));
  const int tid=tid_,lane=tid&63,r32=lane&31,hi=lane>>5; const int wid=__builtin_amdgcn_readfirstlane(tid>>6);
  const long rowbase=(long)b*SEQ; const int q0=qb*QB;
  const bf16*Qw=Q+(rowbase+q0+wid*QBLK)*DM+qcol;
  const bf16*Kh=K+rowbase*DM+qcol,*Vh=V+rowbase*DM+vcol;
  const unsigned lds0=(unsigned)(uintptr_t)shm;
  float*wsf=(float*)(shm+LDS_WS)+wid*64;
  const bf16*ksrc=Kh+(long)lane*DM+wid*8;
  const bf16*vsrc=Vh+(long)(16*(wid&3)+(lane>>2))*DM+(wid>>2)*32+(lane&3)*8;
  const unsigned kdst=lds0+LDS_K+wid*1024, vdst=lds0+LDS_V+wid*1024, qdst=lds0+LDS_OST+wid*4096;
  #define RFL(x) ((unsigned)__builtin_amdgcn_readfirstlane((int)(x)))
  #define DMA_K(t,slot) glds16(ksrc+(long)(t)*KVBLK*DM,RFL(kdst+(slot)))
  #define DMA_V(t,slot) do{ glds16(vsrc+(long)(t)*KVBLK*DM,RFL(vdst+2*(slot))); glds16(vsrc+(long)(t)*KVBLK*DM+64,RFL(vdst+2*(slot)+8192)); }while(0)
  const int vb0=(int)(lds0+LDS_V)+((lane>>4)&1)*32+(lane&3)*8+(4*hi+((lane&15)>>2))*64;
  const char*Kbase=shm+LDS_K; bf16x8 kf[8];
  const lds_cptr shm3=(lds_cptr)shm; const lds_cptr kp0=shm3+LDS_K+hi*1024+r32*16; const lds_cptr vp0=shm3+LDS_V+((lane>>4)&1)*32+(lane&3)*8+(4*hi+((lane&15)>>2))*64;
  const lds_cptr qp0=shm3+LDS_OST+wid*4096+lane*16;
  const int NT=(q0+QB)/KVBLK;
  #pragma unroll
  for(int d0=0;d0<4;++d0)glds16(Qw+(long)r32*DM+d0*16+hi*8,RFL(qdst+d0*1024));
  DMA_K(0,0);DMA_V(0,0);DMA_K(1,SLOTB);
  float mhat=0.f,l_reg=0.f;f32x16 o[4];o[0]=f32x16{};o[1]=f32x16{};o[2]=f32x16{};o[3]=f32x16{};
  const int qrel=wid*QBLK+r32;
  #define CMASK(P0,P1,t) do{int jb_=(t)-(NT-4); if(jb_>=-2)cmask_bias(P0,P1,jb_,qrel,hi,tbl);}while(0)
  #define EX(v) __builtin_amdgcn_exp2f(v)
  bool resc=false;
  #define RESC() do{ if(resc){ asm volatile("s_waitcnt lgkmcnt(0)":::"memory"); \
      _Pragma("unroll") for(int d_=0;d_<4;++d_) _Pragma("unroll") for(int r=0;r<16;++r)o[d_][r]*=wsf[crow(r,hi)]; } }while(0)
  f32x16 pA0,pA1,pB0,pB1;
  int sl_prev=0,sl_cur=0,sl_next=SLOTB;
  #define ROT() do{sl_prev=sl_cur;sl_cur=sl_next;sl_next=(sl_next==(NSLOT-1)*SLOTB)?0:sl_next+SLOTB;}while(0)
  DMA_K(2,2*SLOTB);
  WAIT_BAR(4);
  bf16x8 qr[4];
  #pragma unroll
  for(int d0=0;d0<4;++d0)qr[d0]=LDSQ(qp0+d0*1024);
  qkt(pA0,pA1,Kbase,qr,r32,hi);CMASK(pA0,pA1,0);
  mhat=rowmax(pA0,pA1);
  _Pragma("unroll") for(int r=0;r<16;++r){pA0[r]=EX(pA0[r]-mhat);pA1[r]=EX(pA1[r]-mhat);}
  WAIT_BAR(0);
  DMA_K(3,0);DMA_V(1,SLOTB);
  ROT();
  kload8(kf,kp0+sl_cur);
  WAIT_BAR(3);
  s16x4 vlo[8],vhi[8]; u32x4 pw0,pw1,pw2,pw3;
  #define PKW(P,B) cvtpk_s(P[B],P[B+1])
  #define PAF(k) __builtin_bit_cast(bf16x8,pw##k)
  #define VFR(i) (bf16x8){vlo[i][0],vlo[i][1],vlo[i][2],vlo[i][3],vhi[i][0],vhi[i][1],vhi[i][2],vhi[i][3]}
  #define PIN(x) asm volatile("":"+v"(x))
  #define MX3(a,b,c) __builtin_fmaxf(__builtin_fmaxf((a),(b)),(c))
  #define MF(a,b,c) __builtin_amdgcn_mfma_f32_32x32x16_bf16(a,b,c,0,0,0)
  #define GAPA(MFS,A0,A1,A2,A3,W0,W1,PW) do{ MFS; sacc+=A0; sacc+=A1; sacc+=A2; sacc+=A3; PIN(sacc); W0; W1; PIN(PW); SBAR(); }while(0)
  #define GAPB(MFS,X,B) do{ MFS; X[B]=EX(X[B]-mhat); X[B+1]=EX(X[B+1]-mhat); PIN(X); SBAR(); }while(0)
  #define VRD(i) do{ vlo[i]=vtr(vp_+(((i)>>2)*4096+((i)&3)*1024)); vhi[i]=vtr(vp_+(((i)>>2)*4096+((i)&3)*1024+512)); }while(0)
  #define VRD2(i) do{ vlo[i]=vtr(vp_+((((i)>>2)+2)*4096+((i)&3)*1024)); vhi[i]=vtr(vp_+((((i)>>2)+2)*4096+((i)&3)*1024+512)); }while(0)
  #define KRD(G,j) do{ if(G){ kload2(kf,kp0+sl_next,j); } }while(0)
  #define STEP(C0,C1,P0,P1,t,GK,GV,GL) do{ SBAR(); \
    if(GK){DMA_K((t)+3,sl_cur);} if(GV){DMA_V((t)+1,sl_next);} SBAR(); \
    const lds_cptr vp_=vp0+2*sl_prev; const f32x16 z16_=f32x16{}; \
    VRD(0); SBAR(); float sacc=(P0[0]+P0[1]); \
    GAPA(C0=MF(kf[0],qr[0],z16_), P0[2],P0[3],P0[4],P0[5],     pw0[0]=PKW(P0,0), pw0[1]=PKW(P0,2), pw0); \
    VRD(4); SBAR(); GAPA(C1=MF(kf[1],qr[0],z16_), P0[6],P0[7],P0[8],P0[9],     pw0[2]=PKW(P0,4), pw0[3]=PKW(P0,6), pw0); \
    VRD(1); SBAR(); GAPA(C0=MF(kf[2],qr[1],C0),   P0[10],P0[11],P0[12],P0[13], pw1[0]=PKW(P0,8), pw1[1]=PKW(P0,10), pw1); \
    VRD(5); SBAR(); GAPA(C1=MF(kf[3],qr[1],C1),   P0[14],P0[15],P1[0],P1[1],   pw1[2]=PKW(P0,12),pw1[3]=PKW(P0,14), pw1); \
    VRD(2); SBAR(); GAPA(C0=MF(kf[4],qr[2],C0),   P1[2],P1[3],P1[4],P1[5],     pw2[0]=PKW(P1,0), pw2[1]=PKW(P1,2), pw2); \
    VRD(6); SBAR(); GAPA(C1=MF(kf[5],qr[2],C1),   P1[6],P1[7],P1[8],P1[9],     pw2[2]=PKW(P1,4), pw2[3]=PKW(P1,6), pw2); \
    VRD(3); SBAR(); GAPA(C0=MF(kf[6],qr[3],C0),   P1[10],P1[11],P1[12],P1[13], pw3[0]=PKW(P1,8), pw3[1]=PKW(P1,10), pw3); \
    VRD(7); SBAR(); GAPA(C1=MF(kf[7],qr[3],C1),   P1[14],P1[15],0.f,0.f,       pw3[2]=PKW(P1,12),pw3[3]=PKW(P1,14), pw3); \
    l_reg+=sacc; \
    CMASK(C0,C1,t); \
    { float a=MX3(C0[0],C0[1],C1[0]),bq=MX3(C0[2],C0[3],C1[1]); a=MX3(a,C1[2],C1[3]); \
      _Pragma("unroll") for(int r=4;r<16;r+=4){a=MX3(a,C0[r],C0[r+1]);bq=MX3(bq,C0[r+2],C0[r+3]);a=MX3(a,C1[r],C1[r+1]);bq=MX3(bq,C1[r+2],C1[r+3]);} \
      float rm=__builtin_fmaxf(a,bq); { auto rr=__builtin_amdgcn_permlane32_swap(__float_as_uint(rm),__float_as_uint(rm),false,false); rm=__builtin_fmaxf(__uint_as_float(rr[0]),__uint_as_float(rr[1])); } \
      resc=false; const float grow=rm-mhat; \
      if(__builtin_expect(__any(grow>(float)THRL),0)){ const float dl=__builtin_fmaxf(grow,0.f); mhat+=dl; \
        const float f=__builtin_amdgcn_exp2f(-dl); l_reg*=f; if(hi==0)wsf[r32]=f; resc=true; } } \
    SBAR(); \
    GAPB(o[0]=MF(PAF(0),VFR(0),o[0]), C0,0); \
    VRD2(0); GAPB(o[1]=MF(PAF(0),VFR(4),o[1]), C0,2); \
    VRD2(4); GAPB(o[0]=MF(PAF(1),VFR(1),o[0]), C0,4); \
    VRD2(1); GAPB(o[1]=MF(PAF(1),VFR(5),o[1]), C0,6); \
    VRD2(5); GAPB(o[0]=MF(PAF(2),VFR(2),o[0]), C0,8); \
    VRD2(2); GAPB(o[1]=MF(PAF(2),VFR(6),o[1]), C0,10); \
    VRD2(6); GAPB(o[0]=MF(PAF(3),VFR(3),o[0]), C0,12); \
    VRD2(3); GAPB(o[1]=MF(PAF(3),VFR(7),o[1]), C0,14); \
    VRD2(7); GAPB(o[2]=MF(PAF(0),VFR(0),o[2]), C1,0); \
    KRD(GL,0); GAPB(o[3]=MF(PAF(0),VFR(4),o[3]), C1,2); \
    KRD(GL,1); GAPB(o[2]=MF(PAF(1),VFR(1),o[2]), C1,4); \
    KRD(GL,2); GAPB(o[3]=MF(PAF(1),VFR(5),o[3]), C1,6); \
    KRD(GL,3); GAPB(o[2]=MF(PAF(2),VFR(2),o[2]), C1,8); \
    GAPB(o[3]=MF(PAF(2),VFR(6),o[3]), C1,10); \
    GAPB(o[2]=MF(PAF(3),VFR(3),o[2]), C1,12); \
    GAPB(o[3]=MF(PAF(3),VFR(7),o[3]), C1,14); \
    }while(0)
  int t=1;
  #undef CMASK
  #define CMASK(P0,P1,t) do{}while(0)
  for(;t+7<NT;t+=2){
    STEP(pB0,pB1,pA0,pA1,t,true,true,true);     WAIT_BAR(3); RESC(); ROT();
    STEP(pA0,pA1,pB0,pB1,t+1,true,true,true);   WAIT_BAR(3); RESC(); ROT();
  }
  #undef CMASK
  #define CMASK(P0,P1,t) do{int jb_=(t)-(NT-4); if(jb_>=-2)cmask_bias(P0,P1,jb_,qrel,hi,tbl);}while(0)
  #define ENDW(tt) do{ if((tt)+3<NT){WAIT_BAR(3);} else if((tt)+2<NT){WAIT_BAR(2);} else {WAIT_BAR(0);} }while(0)
  for(;t+1<NT;t+=2){
    STEP(pB0,pB1,pA0,pA1,t,(t+3<NT),(t+1<NT),(t+1<NT));       ENDW(t);   RESC(); ROT();
    STEP(pA0,pA1,pB0,pB1,t+1,(t+4<NT),(t+2<NT),(t+2<NT));     ENDW(t+1); RESC(); ROT();
  }
  STEP(pB0,pB1,pA0,pA1,NT-1,false,false,false); RESC();
  { float sacc=pB0[0]+pB0[1]; _Pragma("unroll") for(int r=2;r<16;++r)sacc+=pB0[r]; _Pragma("unroll") for(int r=0;r<16;++r)sacc+=pB1[r]; l_reg+=sacc;
    pw0=(u32x4){PKW(pB0,0),PKW(pB0,2),PKW(pB0,4),PKW(pB0,6)};pw1=(u32x4){PKW(pB0,8),PKW(pB0,10),PKW(pB0,12),PKW(pB0,14)};pw2=(u32x4){PKW(pB1,0),PKW(pB1,2),PKW(pB1,4),PKW(pB1,6)};pw3=(u32x4){PKW(pB1,8),PKW(pB1,10),PKW(pB1,12),PKW(pB1,14)};
    SBAR(); pv(o,vb0+2*sl_cur,PAF(0),PAF(1),PAF(2),PAF(3)); }
  #undef PKW
  #undef PAF
  #undef VFR
  #undef PIN
  #undef MX3
  #undef MF
  #undef GAPA
  #undef GAPB
  #undef EX
  #undef VRD
  #undef VRD2
  #undef KRD
  #undef STEP
  #undef ENDW
  {auto rr=__builtin_amdgcn_permlane32_swap(__float_as_uint(l_reg),__float_as_uint(l_reg),false,false);l_reg=__uint_as_float(rr[0])+__uint_as_float(rr[1]);}
  if(hi==0)wsf[32+r32]=l_reg;asm volatile("s_waitcnt lgkmcnt(0)":::"memory");
  float rli[16];
  #pragma unroll
  for(int r=0;r<16;++r)rli[r]=__builtin_amdgcn_rcpf(wsf[32+crow(r,hi)]);
  bf16*Ow=O+(rowbase+q0+wid*QBLK)*DM+vcol;
  { bf16*stg=(bf16*)(shm+LDS_OST)+wid*2048;
    #pragma unroll
    for(int h=0;h<2;++h){
      #pragma unroll
      for(int r=0;r<16;++r){const int orow=crow(r,hi);
        #pragma unroll
        for(int d0=0;d0<2;++d0)stg[orow*64+d0*32+r32]=__float2bfloat16(o[2*h+d0][r]*rli[r]);}
      asm volatile("s_waitcnt lgkmcnt(0)":::"memory");
      #pragma unroll
      for(int i=0;i<4;++i){const int row=i*8+(lane>>3),ch=lane&7; const u32x4 v=*(const u32x4*)(stg+row*64+ch*8); ATTN_STORE16(Ow+(long)row*DM+h*64+ch*8,v);}
      asm volatile("s_waitcnt lgkmcnt(0)":::"memory");
    } }
  asm volatile("s_waitcnt lgkmcnt(0)\n\ts_barrier":::"memory");
  #undef DMA_K
  #undef DMA_V
  #undef RFL
  #undef CMASK
  #undef RESC
  #undef ROT
}
constexpr int ATTN_LDS_BYTES=LDS_BYTES;
struct AttnTensors { const bf16* Q; const bf16* K; const bf16* V; bf16* O0; bf16* O1; };
template<int THRL=8> __device__ __forceinline__ void attn_phase(char*lds,const AttnTensors&T,int x,int a,int A8,lds_fptr tbl_all){
  for(int r=0; r*A8<128; ++r){
    const int j=r*A8+((r&1)?(A8-1-a):a); if(j>=128)continue;
    const int qb=31-(j>>2), st=4*x+(j&3), b=st>>4, head=(st>>1)&7, c=st&1;
    attn_unit<THRL>(b,head*128+c*64,head*128,qb,T.Q,T.K,T.V,c?T.O1:T.O0,lds,tbl_all+head*128);
  }
}
#undef SBAR
#undef WAIT_BAR
}

#define GAS __attribute__((address_space(1)))
#define LAS __attribute__((address_space(3)))
typedef unsigned short bf16;
typedef unsigned v4u __attribute__((ext_vector_type(4)));
typedef float f32x4 __attribute__((ext_vector_type(4)));
typedef short bf16x8 __attribute__((ext_vector_type(8)));
typedef GAS unsigned gu32;
typedef GAS unsigned long long gu64;
#define RLX_AGENT __ATOMIC_RELAXED, __HIP_MEMORY_SCOPE_AGENT
#define LDS_WAIT() asm volatile("s_waitcnt lgkmcnt(0)" ::: "memory")
#define VM_WAIT() asm volatile("s_waitcnt vmcnt(0)" ::: "memory")
__device__ __forceinline__ unsigned long long rt() { return __builtin_amdgcn_s_memrealtime(); }
__device__ __forceinline__ unsigned f2bf(float f) { unsigned u = __builtin_bit_cast(unsigned, f); return (u + 0x7fffu + ((u >> 16) & 1u)) >> 16; }
__device__ __forceinline__ unsigned pk2(float lo, float hi) { return f2bf(lo) | (f2bf(hi) << 16); }

#define XB_TMO      128
#define XB_XCNT(j)  (256  + 64 * (j))
#define XB_XSUB(j)  (1280 + 64 * (j))
#define XB_XGEN(j)  (2304 + 64 * (j))
#define XB_TOP      3328
#define XB_TOPGEN   3392
#define XCD_BAR_WORDS 3456
#define XB_SPIN_CAP (1u << 18)

__device__ __forceinline__ unsigned xb_ld(unsigned* p)              { return __hip_atomic_load(p, __ATOMIC_RELAXED, __HIP_MEMORY_SCOPE_AGENT); }
__device__ __forceinline__ unsigned xb_add(unsigned* p, unsigned v) { return __hip_atomic_fetch_add(p, v, __ATOMIC_RELAXED, __HIP_MEMORY_SCOPE_AGENT); }
__device__ __forceinline__ unsigned xb_xcc_id() { return (unsigned)__builtin_amdgcn_s_getreg((3 << 11) | 20) & 0xFu; }
#define XB_SPIN(cond, bar) do { unsigned _sp = 0; while (cond) { __builtin_amdgcn_s_sleep(1); \
    if ((++_sp & 255u) == 0u) { if (xb_ld(&(bar)[XB_TMO])) break; if (_sp > XB_SPIN_CAP) { atomicAdd(&(bar)[XB_TMO], 1u); break; } } } } while (0)

struct XcdBarrier {
    unsigned* bar; unsigned x;
    volatile LAS unsigned* st;
};

__device__ __forceinline__ XcdBarrier xcd_barrier_post(unsigned* bar, volatile LAS unsigned* st) {
    XcdBarrier b; b.bar = bar; b.x = xb_xcc_id(); b.st = st;
    if (threadIdx.x == 0) (void)xb_add(&bar[XB_XCNT(b.x)], 1u);
    return b;
}
__device__ __forceinline__ void xcd_barrier_complete(unsigned* bar, unsigned x, unsigned& nloc, unsigned& nx) {
    const unsigned G = gridDim.x * gridDim.y * gridDim.z;
    unsigned sum, cnt, mine, sp = 0u;
    for (;;) {
        sum = 0u; cnt = 0u; mine = 0u;
#pragma unroll
        for (unsigned j = 0; j < 16; ++j) { const unsigned c = xb_ld(&bar[XB_XCNT(j)]); sum += c; cnt += (c > 0u) ? 1u : 0u; mine = (j == x) ? c : mine; }
        if (sum == G) break;
        __builtin_amdgcn_s_sleep(1);
        if ((++sp & 255u) == 0u) { if (xb_ld(&bar[XB_TMO])) break; if (sp > XB_SPIN_CAP) { atomicAdd(&bar[XB_TMO], 1u); break; } }
    }
    nloc = mine > 0u ? mine : 1u; nx = cnt > 0u ? cnt : 1u;
}

__device__ __forceinline__ void xcd_barrier(const XcdBarrier& b) {
    asm volatile("s_waitcnt vmcnt(0)" ::: "memory");
    __syncthreads();
    if (threadIdx.x == 0) {
        unsigned* bar = b.bar;
        __builtin_amdgcn_s_waitcnt(0);
        unsigned nloc = b.st[0], nx = b.st[1];
        if (nloc == 0u) { xcd_barrier_complete(bar, b.x, nloc, nx); b.st[0] = nloc; b.st[1] = nx; }
        const unsigned old = xb_add(&bar[XB_XSUB(b.x)], 1u);
        const unsigned gen = old / nloc;
        if (old + 1u == (gen + 1u) * nloc) {
            __builtin_amdgcn_fence(__ATOMIC_RELEASE, "agent");
            asm volatile("s_waitcnt vmcnt(0)" ::: "memory");
            const unsigned og = xb_add(&bar[XB_TOP], 1u);
            const unsigned tg = og / nx;
            if (og + 1u == (tg + 1u) * nx) xb_add(&bar[XB_TOPGEN], 1u);
            else XB_SPIN(xb_ld(&bar[XB_TOPGEN]) == tg, bar);
            __builtin_amdgcn_fence(__ATOMIC_ACQUIRE, "agent");
            xb_add(&bar[XB_XGEN(b.x)], 1u);
            asm volatile("s_waitcnt vmcnt(0)" ::: "memory");
        } else {
            XB_SPIN(xb_ld(&bar[XB_XGEN(b.x)]) == gen, bar);
            __builtin_amdgcn_fence(__ATOMIC_ACQUIRE, "agent");
            asm volatile("s_waitcnt vmcnt(0)" ::: "memory");
        }
    }
    __syncthreads();
}

constexpr int NWAVES = 8;
constexpr int NPHASE = 22;
constexpr int ATT_CU_PER_XCD_L0 = 20;
#ifndef MK_N_LAUNCHES
#define MK_N_LAUNCHES 1
#endif
constexpr int N_LAUNCHES = MK_N_LAUNCHES;
static_assert(N_LAUNCHES == 1 || N_LAUNCHES == NPHASE, "MK_N_LAUNCHES is 1 or NPHASE");

constexpr size_t MiB = 1u << 20;
constexpr size_t WS_CTL = 0, CTL_ZERO_BYTES = 1 * MiB;
constexpr size_t WS_TAB = 1 * MiB;
constexpr size_t WS_TOKINFO = 2 * MiB;
constexpr size_t WS_ROWMAP = 2 * MiB + 512 * 1024, WS_ROWW = 2 * MiB + 768 * 1024, WS_BBASE = 3 * MiB;
constexpr size_t WS_WIN = 4 * MiB, WS_WCAT = 68 * MiB  , WS_WBP = 84 * MiB, WS_WOUT = 92 * MiB, WS_POOLB = 108 * MiB;
constexpr size_t WS_WGU_D = 110 * MiB, WS_WD_D = 154 * MiB, WS_WGU_E = 176 * MiB, WS_WD_E = 624 * MiB, WS_AB = 848 * MiB;
constexpr size_t WS_H = WS_AB, WS_XB = WS_AB + 128 * MiB, WS_O0 = WS_AB + 192 * MiB, WS_O1 = WS_AB + 224 * MiB, WS_AO = WS_AB + 256 * MiB, WS_ZB = WS_AB + 288 * MiB;
constexpr size_t WS_MG = WS_AB + 320 * MiB, WS_MERGED = WS_AB + 448 * MiB, WS_ACT_D = WS_AB + 192 * MiB, WS_ACT_E = WS_AB + 128 * MiB;
constexpr size_t WIN_F8_OFF = 16 * MiB;
constexpr size_t WS_X8IN = WS_O0;
constexpr size_t WS_QKV = WS_AB + 604 * MiB, WS_Y = WS_H  , WS_STATS = WS_TAB + 64 * 1024  , WS_XS = WS_QKV, WS_Y2 = WS_QKV, WS_END = WS_AB + 860 * MiB;
constexpr int MAXROWS = 34816;
static_assert(WS_WIN + 2 * (size_t)INW * DM_ * 2 <= WS_WCAT && WS_WCAT + 2 * (size_t)DM_ * DM_ * 2 <= WS_WBP && WS_WBP + 2 * (size_t)DM_ * PW * 2 <= WS_WOUT && WS_WOUT + 2 * (size_t)DM_ * DM_ * 2 <= WS_POOLB && WS_WGU_D + (size_t)2 * FFD * DM_ * 2 <= WS_WD_D && WS_WD_D + (size_t)FFD * DM_ * 2 <= WS_WGU_E, "ws map 1");
static_assert(WS_WGU_E + (size_t)NEXP * 2 * FFE * DM_ * 2 <= WS_WD_E && WS_WD_E + (size_t)NEXP * FFE * DM_ * 2 <= WS_AB, "ws map 2");
static_assert(WS_ACT_E + (size_t)MAXROWS * FFE * 2 <= WS_QKV && WS_XS + (size_t)MAXROWS * DM_ * 2 <= WS_END && WS_Y2 + (size_t)2 * TOK * DM_ * 4 <= WS_END && WS_ACT_D + (size_t)TOK * FFD * 2 <= WS_QKV, "ws map 3");
constexpr int CW_BAR = 4096;
constexpr int CW_CNT = 16384;

constexpr int RING_OFF = 0, RING_BYTES = 131072;
constexpr int ATT_TBL_OFF = 110592;
constexpr int LDSCTL_OFF = RING_BYTES, MISC_OFF = LDSCTL_OFF + 320;
constexpr int LDS_BYTES = 147456;
static_assert(attn_body::ATTN_LDS_BYTES <= ATT_TBL_OFF && ATT_TBL_OFF + 4096 <= RING_BYTES, "attention LDS");

typedef unsigned u32x4_t __attribute__((ext_vector_type(4)));
typedef unsigned u32x2_t __attribute__((ext_vector_type(2)));
template <int CTRL> __device__ __forceinline__ float dppf(float v) { return __int_as_float(__builtin_amdgcn_update_dpp(0, __float_as_int(v), CTRL, 0xF, 0xF, false)); }
__device__ __forceinline__ float row16_sum(float v) {
    v += dppf<0xB1>(v); v += dppf<0x4E>(v); v += dppf<0x141>(v); v += dppf<0x140>(v); return v;
}
__device__ __forceinline__ float wave_sum(float v) {
    v = row16_sum(v);
    const float s0 = __int_as_float(__builtin_amdgcn_readlane(__float_as_int(v), 0)), s1 = __int_as_float(__builtin_amdgcn_readlane(__float_as_int(v), 16));
    const float s2 = __int_as_float(__builtin_amdgcn_readlane(__float_as_int(v), 32)), s3 = __int_as_float(__builtin_amdgcn_readlane(__float_as_int(v), 48));
    return (s0 + s1) + (s2 + s3);
}
__device__ __forceinline__ float ld_f32_agent(const float* p) { return __uint_as_float(__hip_atomic_load((const unsigned*)p, __ATOMIC_RELAXED, __HIP_MEMORY_SCOPE_AGENT)); }
__device__ __forceinline__ unsigned ld_u32_agent(const unsigned* p) { return __hip_atomic_load(p, __ATOMIC_RELAXED, __HIP_MEMORY_SCOPE_AGENT); }


__device__ __forceinline__ void p0_transpose_item(const float* W, int ldw, int K, int N, bf16* WT, int mode, LAS float* scr, int item, int lane) {
    const int nblk = N / 32, kb = item / nblk, nb = item % nblk, k0 = 64 * kb, n0 = 32 * nb;
    const int d0 = (mode == 0) ? n0 : (((n0 >> 7) << 8) + (n0 & 127) + (mode == 2 ? 128 : 0));
    float tv[32];
#pragma unroll
    for (int i = 0; i < 32; ++i) tv[i] = W[(size_t)(k0 + 2 * i + (lane >> 5)) * ldw + n0 + (lane & 31)];
#pragma unroll
    for (int i = 0; i < 32; ++i) scr[(2 * i + (lane >> 5)) * 33 + (lane & 31)] = tv[i];
    LDS_WAIT(); asm volatile("" ::: "memory");
    const int c = lane & 7;
#pragma unroll
    for (int j = 0; j < 4; ++j) { const int n = (lane >> 3) + 8 * j; const LAS float* s = scr + (8 * c) * 33 + n;
        v4u o; o.x = pk2(s[0 * 33], s[1 * 33]); o.y = pk2(s[2 * 33], s[3 * 33]); o.z = pk2(s[4 * 33], s[5 * 33]); o.w = pk2(s[6 * 33], s[7 * 33]);
        *(GAS v4u*)(WT + (size_t)(d0 + n) * K + k0 + 8 * c) = o; }
    LDS_WAIT(); asm volatile("" ::: "memory");
}

__device__ __forceinline__ void p0_item_load(const float* W, int ldw, int N, int item, int lane, float (&tv)[32]) {
    const int nblk = N / 32, kb = item / nblk, nb = item % nblk, k0 = 64 * kb, n0 = 32 * nb;
#pragma unroll
    for (int i = 0; i < 32; ++i) tv[i] = __builtin_nontemporal_load(W + (size_t)(k0 + 2 * i + (lane >> 5)) * ldw + n0 + (lane & 31));
}
__device__ __forceinline__ void p0_item8_finish(const float (&tv)[32], int K, int N, unsigned char* WT, int mode, float scale, LAS float* scr, int item, int lane) {
    const int nblk = N / 32, kb = item / nblk, nb = item % nblk, k0 = 64 * kb, n0 = 32 * nb;
    const int d0 = (mode == 0) ? n0 : (((n0 >> 7) << 8) + (n0 & 127) + (mode == 2 ? 128 : 0));
#pragma unroll
    for (int i = 0; i < 32; ++i) scr[(2 * i + (lane >> 5)) * 33 + (lane & 31)] = tv[i];
    LDS_WAIT(); asm volatile("" ::: "memory");
    const int c = lane & 3;
#pragma unroll
    for (int j = 0; j < 2; ++j) { const int n = (lane >> 2) + 16 * j; const LAS float* p = scr + (16 * c) * 33 + n;
        v4u o;
        o.x = pg8::pk4_fp8(p[0 * 33] * scale, p[1 * 33] * scale, p[2 * 33] * scale, p[3 * 33] * scale);     o.y = pg8::pk4_fp8(p[4 * 33] * scale, p[5 * 33] * scale, p[6 * 33] * scale, p[7 * 33] * scale);
        o.z = pg8::pk4_fp8(p[8 * 33] * scale, p[9 * 33] * scale, p[10 * 33] * scale, p[11 * 33] * scale);   o.w = pg8::pk4_fp8(p[12 * 33] * scale, p[13 * 33] * scale, p[14 * 33] * scale, p[15 * 33] * scale);
        *(GAS v4u*)(WT + (size_t)(d0 + n) * K + k0 + 16 * c) = o; }
    LDS_WAIT(); asm volatile("" ::: "memory");
}
__device__ __forceinline__ void p0_transpose_item8(const float* W, int ldw, int K, int N, unsigned char* WT, int mode, float scale, LAS float* scr, int item, int lane) {
    float tv[32]; p0_item_load(W, ldw, N, item, lane, tv); p0_item8_finish(tv, K, N, WT, mode, scale, scr, item, lane);
}
constexpr float W8_SCALE_UP = 256.0f, W8_SCALE_DOWN = 1024.0f, X8_SCALE = 4.0f;

constexpr int CONV_NB_PRE = 4160, CONV_BPM = (DM_ / 128) * (FFE / 128), CONV_TOTB = CONV_NB_PRE + 24 * CONV_BPM;
struct ConvBlk { const float* src; unsigned char* dst; int ldw, pitch, f8; float sc; };
#define CONV_PTR_PARAMS unsigned char* wsb, const float* in1, const float* in6, const float* in7, const float* in8, const float* in12, const float* in13, const float* in14, const float* in16, const float* in17, const float* in18
#define CONV_PTR_ARGS P_ws, P_in1, P_in6, P_in7, P_in8, P_in12, P_in13, P_in14, P_in16, P_in17, P_in18
__device__ __forceinline__ ConvBlk conv_decode(int b, CONV_PTR_PARAMS) {
    ConvBlk c;
    if (b >= CONV_NB_PRE) {
        const int bb = b - CONV_NB_PRE, j = bb / CONV_BPM, r = bb - j * CONV_BPM, kind = j >> 3, e = j & 7; const int K = kind == 2 ? FFE : DM_, N = kind == 2 ? DM_ : FFE, nbn = N / 128, kb = r / nbn, nb = r - kb * nbn;
        const float* sk = in16; if (kind == 1) sk = in17; if (kind == 2) sk = in18;
        c.src = sk + (size_t)e * DM_ * FFE + (size_t)(128 * kb) * N + 128 * nb; c.ldw = N; c.pitch = K; c.f8 = 1; c.sc = kind == 2 ? W8_SCALE_DOWN : W8_SCALE_UP;
        c.dst = (kind == 2 ? wsb + WS_WD_E + (size_t)e * DM_ * FFE + (size_t)(128 * nb) * K : wsb + WS_WGU_E + (size_t)e * 2 * FFE * DM_ + (size_t)(256 * nb + 128 * kind) * K) + 128 * kb;
        return c; }
    int r = b; const float* src = nullptr; unsigned char* dst = nullptr; int ldw = 0, K = 0, N = 0, f8 = 0, mode = 0, pitch = 0; bool hit = false;
#define CONV_JOB(CNT, SRC, LDW, KK, NN, DST, F8, MODE) if (!hit) { if (r < (CNT)) { src = (SRC); ldw = (LDW); K = (KK); N = (NN); dst = (DST); f8 = (F8); mode = (MODE) & 3; pitch = ((MODE) >> 2) ? ((MODE) >> 2) : ((F8) ? (KK) : 2 * (KK)); hit = true; } else r -= (CNT); }
    CONV_JOB(128, in6, DM_, AW, DM_, wsb + WS_WCAT, 0, (4096 << 2))
    CONV_JOB(128, in7, DM_, PW, DM_, wsb + WS_WBP, 0, 0)
    CONV_JOB(256, in8, DM_, DM_, DM_, wsb + WS_WOUT, 0, 0)
    CONV_JOB(704, in12, FFD, DM_, FFD, wsb + WS_WGU_D, 1, 1)
    CONV_JOB(704, in13, FFD, DM_, FFD, wsb + WS_WGU_D, 1, 2)
    CONV_JOB(704, in14, DM_, FFD, DM_, wsb + WS_WD_D, 1, 0)
    CONV_JOB(512, in1 + (size_t)DM_ * INW, INW, DM_, 4096, wsb + WS_WIN + (size_t)INW * DM_ * 2, 0, 0)
    CONV_JOB(512, in1 + (size_t)DM_ * INW + 4096, INW, DM_, 4096, wsb + WS_WIN + (size_t)INW * DM_ * 2 + WIN_F8_OFF, 1, 0)
    CONV_JOB(128, in6 + (size_t)AW * DM_, DM_, AW, DM_, wsb + WS_WCAT + (size_t)DM_ * DM_ * 2, 0, (4096 << 2))
    CONV_JOB(128, in7 + (size_t)PW * DM_, DM_, PW, DM_, wsb + WS_WBP + (size_t)DM_ * PW * 2, 0, 0)
    CONV_JOB(256, in8 + (size_t)DM_ * DM_, DM_, DM_, DM_, wsb + WS_WOUT + (size_t)DM_ * DM_ * 2, 0, 0)
#undef CONV_JOB
    const int nbn = N / 128, kb = r / nbn, nb = r - kb * nbn;
    (void)K; c.src = src + (size_t)(128 * kb) * ldw + 128 * nb; c.ldw = ldw; c.f8 = f8; c.sc = W8_SCALE_UP; c.pitch = pitch;
    c.dst = dst + (size_t)(mode == 0 ? 128 * nb : 256 * nb + 128 * (mode - 1)) * c.pitch + (f8 ? 128 * kb : 256 * kb);
    return c;
}
constexpr int CW_CONV = 16384 + 64 * 16;
__device__ __forceinline__ void conv_pool(LAS unsigned char* lds, volatile LAS unsigned* MISC, int tid) {
    const int lane = tid & 63, wave = tid >> 6;
    unsigned char* const P_ws = arg_ws(); const float* const P_in1 = arg_in(1); const float* const P_in6 = arg_in(6); const float* const P_in7 = arg_in(7); const float* const P_in8 = arg_in(8); const float* const P_in12 = arg_in(12);
    const float* const P_in13 = arg_in(13); const float* const P_in14 = arg_in(14); const float* const P_in16 = arg_in(16); const float* const P_in17 = arg_in(17); const float* const P_in18 = arg_in(18);
    unsigned* const ctr = (unsigned*)(P_ws + WS_CTL) + CW_CONV;
    f32x4 la[8], lb[8];
#define CONV_CLAIM(slot) do { if (tid == 0) MISC[24 + (slot)] = __hip_atomic_fetch_add(ctr, 1u, __ATOMIC_RELAXED, __HIP_MEMORY_SCOPE_AGENT); } while (0)
#define CONV_LOAD(R, blk) do { if ((blk) < CONV_TOTB) { const ConvBlk cb_ = conv_decode(blk, CONV_PTR_ARGS); _Pragma("unroll") for (int i = 0; i < 8; ++i) { const int row = 16 * wave + 2 * i + (lane >> 5); \
        R[i] = __builtin_nontemporal_load((const f32x4*)(cb_.src + (size_t)row * cb_.ldw + 4 * (lane & 31))); } } } while (0)
#define CONV_STAGE(R, buf) do { _Pragma("unroll") for (int i = 0; i < 8; ++i) { const int row = 16 * wave + 2 * i + (lane >> 5), col = (4 * (lane & 31) + 16 * (row >> 4)) & 127; \
        *(LAS f32x4*)(lds + (buf) * 65536 + (row * 128 + col) * 4) = R[i]; } } while (0)
#define CONV_OUT(blk, buf) do { const ConvBlk cb_ = conv_decode(blk, CONV_PTR_ARGS); const float sc = cb_.sc; \
        const int c = tid & 7, pr = tid >> 3;                         \
        const LAS attn_body::f32x2_t* q = (const LAS attn_body::f32x2_t*)(lds + (buf) * 65536) + ((16 * c) * 128 + ((2 * pr + 16 * c) & 127)) / 2; \
        attn_body::f32x2_t e[16]; _Pragma("unroll") for (int i = 0; i < 16; ++i) e[i] = q[i * 64]; \
        if (cb_.f8) { v4u o0, o1; \
            o0.x = pg8::pk4_fp8(e[0].x * sc, e[1].x * sc, e[2].x * sc, e[3].x * sc);     o0.y = pg8::pk4_fp8(e[4].x * sc, e[5].x * sc, e[6].x * sc, e[7].x * sc); \
            o0.z = pg8::pk4_fp8(e[8].x * sc, e[9].x * sc, e[10].x * sc, e[11].x * sc);   o0.w = pg8::pk4_fp8(e[12].x * sc, e[13].x * sc, e[14].x * sc, e[15].x * sc); \
            o1.x = pg8::pk4_fp8(e[0].y * sc, e[1].y * sc, e[2].y * sc, e[3].y * sc);     o1.y = pg8::pk4_fp8(e[4].y * sc, e[5].y * sc, e[6].y * sc, e[7].y * sc); \
            o1.z = pg8::pk4_fp8(e[8].y * sc, e[9].y * sc, e[10].y * sc, e[11].y * sc);   o1.w = pg8::pk4_fp8(e[12].y * sc, e[13].y * sc, e[14].y * sc, e[15].y * sc); \
            *(GAS v4u*)(cb_.dst + (size_t)(2 * pr) * cb_.pitch + 16 * c) = o0; *(GAS v4u*)(cb_.dst + (size_t)(2 * pr + 1) * cb_.pitch + 16 * c) = o1; } \
        else { _Pragma("unroll") for (int h = 0; h < 2; ++h) { v4u o0, o1; \
                o0.x = pk2(h ? e[0].y : e[0].x, h ? e[1].y : e[1].x); o0.y = pk2(h ? e[2].y : e[2].x, h ? e[3].y : e[3].x); o0.z = pk2(h ? e[4].y : e[4].x, h ? e[5].y : e[5].x); o0.w = pk2(h ? e[6].y : e[6].x, h ? e[7].y : e[7].x); \
                o1.x = pk2(h ? e[8].y : e[8].x, h ? e[9].y : e[9].x); o1.y = pk2(h ? e[10].y : e[10].x, h ? e[11].y : e[11].x); o1.z = pk2(h ? e[12].y : e[12].x, h ? e[13].y : e[13].x); o1.w = pk2(h ? e[14].y : e[14].x, h ? e[15].y : e[15].x); \
                GAS v4u* d = (GAS v4u*)(cb_.dst + (size_t)(2 * pr + h) * cb_.pitch + 32 * c); d[0] = o0; d[1] = o1; } } } while (0)
    CONV_CLAIM(0); CONV_CLAIM(1); CONV_CLAIM(2);
    __syncthreads();
    int cur = (int)MISC[24], n1 = (int)MISC[25], n2 = (int)MISC[26];
    CONV_LOAD(la, cur); CONV_LOAD(lb, n1);
    if (cur < CONV_TOTB) CONV_STAGE(la, 0);
    __syncthreads();
    CONV_LOAD(la, n2);
    int par = 0;
    while (cur < CONV_TOTB) {
        unsigned cl = 0u; if (tid == 0) cl = __hip_atomic_fetch_add(ctr, 1u, __ATOMIC_RELAXED, __HIP_MEMORY_SCOPE_AGENT);
        CONV_OUT(cur, par);
        if (n1 < CONV_TOTB) CONV_STAGE(lb, par ^ 1);
        if (tid == 0) MISC[24] = cl;
        __syncthreads();
        { const int n3 = (int)MISC[24]; cur = n1; n1 = n2; n2 = n3; par ^= 1; }
        CONV_LOAD(lb, n2);
        if (cur >= CONV_TOTB) break;
        cl = 0u; if (tid == 0) cl = __hip_atomic_fetch_add(ctr, 1u, __ATOMIC_RELAXED, __HIP_MEMORY_SCOPE_AGENT);
        CONV_OUT(cur, par);
        if (n1 < CONV_TOTB) CONV_STAGE(la, par ^ 1);
        if (tid == 0) MISC[25] = cl;
        __syncthreads();
        { const int n3 = (int)MISC[25]; cur = n1; n1 = n2; n2 = n3; par ^= 1; }
        CONV_LOAD(la, n2);
    }
    __syncthreads();
#undef CONV_CLAIM
#undef CONV_LOAD
#undef CONV_STAGE
#undef CONV_OUT
}

__device__ __forceinline__ void ph_prologue(const Args& a, LAS unsigned char* lds, int vcu, int G, int wave, int lane, int tid) {
    unsigned char* ws = arg_ws();
    LAS float* scr = (LAS float*)(lds + RING_OFF + wave * 16384);
    const int gw = vcu * NWAVES + wave, NGW = G * NWAVES;
    for (int jb = -6; jb < 2; jb += 2) {
        const float* src; bf16* dst; int K, N, mode = 0, ldw = 0; bool f8 = false; float sc8 = W8_SCALE_UP;
        if (jb == -4)     { src = arg_in(1) + 4096; dst = (bf16*)(ws + WS_WIN + WIN_F8_OFF); K = DM_; N = 4096; ldw = INW; f8 = true; }
        else if (jb == 0) { src = arg_in(1); dst = (bf16*)(ws + WS_WIN); K = DM_; N = 4096; ldw = INW; }
        else continue;
        if (ldw == 0) ldw = N;
        const int nitems = (K / 64) * (N / 32);
        if (!f8) { for (int it = gw; it < nitems; it += NGW) p0_transpose_item(src, ldw, K, N, dst, mode, scr, it, lane); }
        else { for (int it = gw; it < nitems; it += NGW) p0_transpose_item8(src, ldw, K, N, (unsigned char*)dst, mode, sc8, scr, it, lane); }
    }
    {
        const float* x = arg_in(0); bf16* xb = (bf16*)(ws + WS_XB); unsigned char* x8 = (unsigned char*)(ws + WS_X8IN);
        const size_t nchunk = (size_t)TOK * DM_ / 8;
        for (size_t i = (size_t)gw * 64 + lane; i < nchunk; i += (size_t)NGW * 64) {
            const f32x4 a0 = *(const GAS f32x4*)(x + 8 * i), a1 = *(const GAS f32x4*)(x + 8 * i + 4);
            v4u o; o.x = pk2(a0.x, a0.y); o.y = pk2(a0.z, a0.w); o.z = pk2(a1.x, a1.y); o.w = pk2(a1.z, a1.w);
            *(GAS v4u*)(xb + 8 * i) = o;
            u32x2_t o8; o8.x = pg8::pk4_fp8(a0.x * X8_SCALE, a0.y * X8_SCALE, a0.z * X8_SCALE, a0.w * X8_SCALE); o8.y = pg8::pk4_fp8(a1.x * X8_SCALE, a1.y * X8_SCALE, a1.z * X8_SCALE, a1.w * X8_SCALE);
            *(GAS u32x2_t*)(x8 + 8 * i) = o8; }
    }
    {
        const float* pw = arg_in(4); const float* ps = arg_in(5); bf16* pb = (bf16*)(ws + WS_POOLB);
        const int nchunk = 2 * 4 * 256 * 256 / 8;
        for (int i = gw * 64 + lane; i < nchunk; i += NGW * 64) {
            const int f = 8 * i, e0 = f & 255, g = (f >> 16) & 3, l = f >> 18;
            const float* sp = ps + l * PW + 256 * g + e0;
            const f32x4 a0 = *(const GAS f32x4*)(pw + f), a1 = *(const GAS f32x4*)(pw + f + 4), s0 = *(const GAS f32x4*)sp, s1 = *(const GAS f32x4*)(sp + 4);
            v4u o; o.x = pk2(a0.x * s0.x, a0.y * s0.y); o.y = pk2(a0.z * s0.z, a0.w * s0.w); o.z = pk2(a1.x * s1.x, a1.y * s1.y); o.w = pk2(a1.z * s1.z, a1.w * s1.w);
            *(GAS v4u*)(pb + f) = o; }
    }
    if (vcu == 0) {
        float* tab = (float*)(ws + WS_TAB);
        if (wave < 2) {
            const float* lv = arg_in(2) + wave * 256;
            const float p = wave_sum(lv[lane] * lv[64 + lane]), q = wave_sum(lv[128 + lane] * lv[192 + lane]);
            const float lam_init = (wave == 0) ? 0.2f : 0.35550906759096926f;
            if (lane == 0) tab[64 * wave] = expf(p) - expf(q) + lam_init;
        }
        const float* rb = arg_in(9);
        for (int i = tid; i < 1024; i += NWAVES * 64) {
            const int h = i >> 7, n = i & 127; int bk;
            if (n < 16) bk = n; else { bk = 16 + (int)(logf((float)n / 16.0f) / 2.0794415416798357f * 16.0f); bk = bk > 31 ? 31 : bk; }
            tab[1024 + i] = (rb[bk * 8 + h] - rb[31 * 8 + h]) * 1.4426950408889634f;
        }
    }
}

__device__ __forceinline__ void ph_finalize(const Args& a, int L, int vcu, int G, int wave, int lane) {
    unsigned char* ws = arg_ws();
    const int gw = vcu * NWAVES + wave, NGW = G * NWAVES;
    const bf16* O0 = (const bf16*)(ws + WS_O0); const bf16* O1 = (const bf16*)(ws + WS_O1); const bf16* U = (const bf16*)(ws + WS_QKV) + (size_t)3 * TOK * 1024;
    bf16* AZ = (bf16*)(ws + WS_AO);
    const float lam = ld_f32_agent((const float*)(ws + WS_TAB) + 64 * L);
    const float lam_init = (L == 0) ? 0.2f : 0.35550906759096926f;
    const float* sw = arg_in(3) + L * 128 + (16 * lane & 127);
    const int g = lane >> 4, w = 2 << g;
    const int R = (TOK + NGW - 1) / NGW, t0 = gw * R, t1 = (t0 + R < TOK) ? t0 + R : TOK;
    for (int t = t0; t < t1; ++t) {
        {
            const v4u* p0 = (const v4u*)(O0 + (size_t)t * 1024 + 16 * lane); const v4u* p1 = (const v4u*)(O1 + (size_t)t * 1024 + 16 * lane);
            const v4u a0 = p0[0], a1 = p0[1], b0 = p1[0], b1 = p1[1];
            const unsigned aw[8] = {a0.x, a0.y, a0.z, a0.w, a1.x, a1.y, a1.z, a1.w}, bw[8] = {b0.x, b0.y, b0.z, b0.w, b1.x, b1.y, b1.z, b1.w};
            float o[16]; float ss = 0.f;
#pragma unroll
            for (int i = 0; i < 8; ++i) { o[2 * i] = pg8::bflo(aw[i]) - lam * pg8::bflo(bw[i]); o[2 * i + 1] = pg8::bfhi(aw[i]) - lam * pg8::bfhi(bw[i]); ss += o[2 * i] * o[2 * i] + o[2 * i + 1] * o[2 * i + 1]; }
            ss += dppf<0xB1>(ss); ss += dppf<0x4E>(ss); ss += dppf<0x141>(ss);
            const float r = (1.0f - lam_init) / sqrtf(ss * (1.0f / 128.0f) + LN_EPS);
            float swv[16];
#pragma unroll
            for (int i = 0; i < 4; ++i) { const f32x4 w4 = *(const f32x4*)(sw + 4 * i); swv[4 * i] = w4.x; swv[4 * i + 1] = w4.y; swv[4 * i + 2] = w4.z; swv[4 * i + 3] = w4.w; }
            v4u q0, q1;
            q0.x = pk2(o[0] * r * swv[0], o[1] * r * swv[1]); q0.y = pk2(o[2] * r * swv[2], o[3] * r * swv[3]); q0.z = pk2(o[4] * r * swv[4], o[5] * r * swv[5]); q0.w = pk2(o[6] * r * swv[6], o[7] * r * swv[7]);
            q1.x = pk2(o[8] * r * swv[8], o[9] * r * swv[9]); q1.y = pk2(o[10] * r * swv[10], o[11] * r * swv[11]); q1.z = pk2(o[12] * r * swv[12], o[13] * r * swv[13]); q1.w = pk2(o[14] * r * swv[14], o[15] * r * swv[15]);
            v4u* po = (v4u*)(AZ + (size_t)t * 2048 + 16 * lane); po[0] = q0; po[1] = q1;
        }
    }
    {
        float s[16];
#pragma unroll
        for (int i = 0; i < 16; ++i) s[i] = 0.f;
        for (int t = t0; t < t1; ++t) {
            const int pos = t & (SEQ - 1); const int nwin = (pos + 1) < w ? (pos + 1) : w;
            float u0[16];
            if (t == t0 || pos == 0) {
#pragma unroll
                for (int i = 0; i < 16; ++i) s[i] = 0.f;
#pragma unroll
                for (int hb = 0; hb < 4; ++hb) {
                    v4u c0[4], c1[4];
#pragma unroll
                    for (int dd = 0; dd < 4; ++dd) { const int d = 4 * hb + dd; const v4u* p = (const v4u*)(U + (size_t)(t - (d < nwin ? d : 0)) * 1024 + 16 * lane); c0[dd] = p[0]; c1[dd] = p[1]; }
#pragma unroll
                    for (int dd = 0; dd < 4; ++dd) { const int d = 4 * hb + dd; const float mk = d < nwin ? 1.f : 0.f;
                        const unsigned cw[8] = {c0[dd].x, c0[dd].y, c0[dd].z, c0[dd].w, c1[dd].x, c1[dd].y, c1[dd].z, c1[dd].w};
#pragma unroll
                        for (int i = 0; i < 8; ++i) { const float lo = pg8::bflo(cw[i]), hi = pg8::bfhi(cw[i]); s[2 * i] += mk * lo; s[2 * i + 1] += mk * hi; if (d == 0) { u0[2 * i] = lo; u0[2 * i + 1] = hi; } } }
                }
            } else {
                const bool drop = pos >= w; const float mk = drop ? 1.f : 0.f;
                const v4u* pn = (const v4u*)(U + (size_t)t * 1024 + 16 * lane); const v4u* pd = (const v4u*)(U + (size_t)(t - (drop ? w : 0)) * 1024 + 16 * lane);
                const v4u n0 = pn[0], n1 = pn[1], d0 = pd[0], d1 = pd[1];
                const unsigned nw[8] = {n0.x, n0.y, n0.z, n0.w, n1.x, n1.y, n1.z, n1.w}, dw[8] = {d0.x, d0.y, d0.z, d0.w, d1.x, d1.y, d1.z, d1.w};
#pragma unroll
                for (int i = 0; i < 8; ++i) { u0[2 * i] = pg8::bflo(nw[i]); u0[2 * i + 1] = pg8::bfhi(nw[i]);
                    s[2 * i] += u0[2 * i] - mk * pg8::bflo(dw[i]); s[2 * i + 1] += u0[2 * i + 1] - mk * pg8::bfhi(dw[i]); }
            }
            const float inv = 1.0f / (float)nwin;
            v4u q0, q1;
            q0.x = pk2(s[0] * inv - u0[0], s[1] * inv - u0[1]); q0.y = pk2(s[2] * inv - u0[2], s[3] * inv - u0[3]); q0.z = pk2(s[4] * inv - u0[4], s[5] * inv - u0[5]); q0.w = pk2(s[6] * inv - u0[6], s[7] * inv - u0[7]);
            q1.x = pk2(s[8] * inv - u0[8], s[9] * inv - u0[9]); q1.y = pk2(s[10] * inv - u0[10], s[11] * inv - u0[11]); q1.z = pk2(s[12] * inv - u0[12], s[13] * inv - u0[13]); q1.w = pk2(s[14] * inv - u0[14], s[15] * inv - u0[15]);
            v4u* po = (v4u*)(AZ + (size_t)t * 2048 + 1024 + 16 * lane); po[0] = q0; po[1] = q1;
        }
    }
}

#define LN_COL(j) (512 * ((j) >> 1) + 4 * ((j) & 1))
__device__ __forceinline__ void ln_load_bf16(f32x4 (&v)[8], const bf16* row, int lane) {
    const GAS v4u* p = (const GAS v4u*)(row + 8 * lane);
#pragma unroll
    for (int jj = 0; jj < 4; ++jj) { const v4u w = p[64 * jj]; v[2 * jj] = (f32x4){pg8::bflo(w.x), pg8::bfhi(w.x), pg8::bflo(w.y), pg8::bfhi(w.y)}; v[2 * jj + 1] = (f32x4){pg8::bflo(w.z), pg8::bfhi(w.z), pg8::bflo(w.w), pg8::bfhi(w.w)}; }
}
__device__ __forceinline__ void ln_store_bf16(const f32x4 (&v)[8], bf16* row, int lane) {
    GAS v4u* p = (GAS v4u*)(row + 8 * lane);
#pragma unroll
    for (int jj = 0; jj < 4; ++jj) { v4u w; w.x = pk2(v[2 * jj].x, v[2 * jj].y); w.y = pk2(v[2 * jj].z, v[2 * jj].w); w.z = pk2(v[2 * jj + 1].x, v[2 * jj + 1].y); w.w = pk2(v[2 * jj + 1].z, v[2 * jj + 1].w); p[64 * jj] = w; }
}
__device__ __forceinline__ void ln_store_fp8(const f32x4 (&v)[8], unsigned char* row, int lane) {
    GAS u32x2_t* p = (GAS u32x2_t*)(row + 8 * lane);
#pragma unroll
    for (int jj = 0; jj < 4; ++jj) { u32x2_t w; w.x = pg8::pk4_fp8(v[2 * jj].x * X8_SCALE, v[2 * jj].y * X8_SCALE, v[2 * jj].z * X8_SCALE, v[2 * jj].w * X8_SCALE);
        w.y = pg8::pk4_fp8(v[2 * jj + 1].x * X8_SCALE, v[2 * jj + 1].y * X8_SCALE, v[2 * jj + 1].z * X8_SCALE, v[2 * jj + 1].w * X8_SCALE); p[64 * jj] = w; }
}
__device__ __forceinline__ void ln_core(f32x4 (&v)[8], const float* gp, const float* bp, int lane) {
    float s = 0.f;
#pragma unroll
    for (int j = 0; j < 8; ++j) s += (v[j].x + v[j].y) + (v[j].z + v[j].w);
    const float mean = wave_sum(s) * (1.f / DM_); float s2 = 0.f;
#pragma unroll
    for (int j = 0; j < 8; ++j) { v[j] = v[j] - mean; s2 += (v[j].x * v[j].x + v[j].y * v[j].y) + (v[j].z * v[j].z + v[j].w * v[j].w); }
    const float rstd = 1.f / sqrtf(wave_sum(s2) * (1.f / DM_) + LN_EPS);
    int lo8 = 8 * lane; asm volatile("" : "+v"(lo8)); const float* gl = gp + lo8; const float* bl = bp + lo8;
#pragma unroll
    for (int j = 0; j < 8; ++j) { const f32x4 gg = *(const f32x4*)(gl + LN_COL(j)), bb = *(const f32x4*)(bl + LN_COL(j)); v[j] = v[j] * rstd * gg + bb; }
}
__device__ __forceinline__ void ln_core2(f32x4 (&va)[8], f32x4 (&vb)[8], const float* gp, const float* bp, int lane, float* sta, float* stb) {
    float sa = 0.f, sb = 0.f;
#pragma unroll
    for (int j = 0; j < 8; ++j) { sa += (va[j].x + va[j].y) + (va[j].z + va[j].w); sb += (vb[j].x + vb[j].y) + (vb[j].z + vb[j].w); }
    const float ma = wave_sum(sa) * (1.f / DM_), mb = wave_sum(sb) * (1.f / DM_); float qa = 0.f, qb = 0.f;
#pragma unroll
    for (int j = 0; j < 8; ++j) { va[j] = va[j] - ma; vb[j] = vb[j] - mb; qa += (va[j].x * va[j].x + va[j].y * va[j].y) + (va[j].z * va[j].z + va[j].w * va[j].w); qb += (vb[j].x * vb[j].x + vb[j].y * vb[j].y) + (vb[j].z * vb[j].z + vb[j].w * vb[j].w); }
    const float ra = 1.f / sqrtf(wave_sum(qa) * (1.f / DM_) + LN_EPS), rb = 1.f / sqrtf(wave_sum(qb) * (1.f / DM_) + LN_EPS);
    int lo8 = 8 * lane; asm volatile("" : "+v"(lo8)); const float* gl = gp + lo8; const float* bl = bp + lo8;
#pragma unroll
    for (int j = 0; j < 8; ++j) { const f32x4 gg = *(const f32x4*)(gl + LN_COL(j)), bb = *(const f32x4*)(bl + LN_COL(j)); va[j] = va[j] * ra * gg + bb; vb[j] = vb[j] * rb * gg + bb; }
    if (lane == 0) { sta[0] = ma; sta[1] = ra; stb[0] = mb; stb[1] = rb; }
}
template <int MODE>
__device__ __forceinline__ void ph_ln(const bf16* src, const bf16* y2, const float* gp, const float* bp, float* st, const float* g1, const float* b1, float* dst, bf16* dstb, unsigned char* dst8, int vcu, int G, int wave, int lane) {
    const int gw = vcu * NWAVES + wave, NGW = G * NWAVES;
    static_assert(TOK % 2 == 0, "rows are taken in pairs");
    if (MODE == 2) {
        for (int m = gw; m < TOK; m += NGW) {
            f32x4 v[8], a[8], b[8];
            ln_load_bf16(v, src + (size_t)m * DM_, lane); ln_load_bf16(a, y2 + (size_t)(2 * m) * DM_, lane); ln_load_bf16(b, y2 + (size_t)(2 * m + 1) * DM_, lane);
            const float mu = st[2 * m], rs = st[2 * m + 1];
            int lo8 = 8 * lane; asm volatile("" : "+v"(lo8));
            const float* g1l = g1 + lo8; const float* b1l = b1 + lo8;
#pragma unroll
            for (int j = 0; j < 8; ++j) { const f32x4 gg = *(const f32x4*)(g1l + LN_COL(j)), bb = *(const f32x4*)(b1l + LN_COL(j)); v[j] = ((v[j] - mu) * rs * gg + bb) * ALPHA + (a[j] + b[j]); }
            ln_core(v, gp, bp, lane);
            GAS f32x4* o = (GAS f32x4*)(dst + (size_t)m * DM_ + 8 * lane);
#pragma unroll
            for (int j = 0; j < 8; ++j) o[LN_COL(j) / 4] = v[j];
        }
        return;
    }
    for (int mp = gw; mp < TOK / 2; mp += NGW) {
        f32x4 v[2][8];
#pragma unroll
        for (int q = 0; q < 2; ++q) ln_load_bf16(v[q], src + (size_t)(mp + q * (TOK / 2)) * DM_, lane);
        ln_core2(v[0], v[1], gp, bp, lane, st + 2 * mp, st + 2 * (mp + TOK / 2));
#pragma unroll
        for (int q = 0; q < 2; ++q) { const int m = mp + q * (TOK / 2);
            if (dstb) ln_store_bf16(v[q], dstb + (size_t)m * DM_, lane);
            if (dst8) ln_store_fp8(v[q], dst8 + (size_t)m * DM_, lane); }
    }
}
__device__ __forceinline__ void ph_ln_router(const Args& a, const bf16* src, const float* gp, const float* bp, float* st, bf16* dstb, LAS unsigned char* lds, volatile LAS unsigned* MISC, int vcu, int G, int wave, int lane, int tid) {
    unsigned char* ws = arg_ws();
    const int gw = vcu * NWAVES + wave, NGW = G * NWAVES;
    LAS float* rwT = (LAS float*)(lds + RING_OFF);
    const float* rw = arg_in(15);
    for (int i = tid; i < DM_ * NEXP; i += NWAVES * 64) rwT[(i & 7) * DM_ + (i >> 3)] = rw[i];
    if (tid < 8) MISC[16 + tid] = 0u;
    __syncthreads();
    int* tokinfo = (int*)(ws + WS_TOKINFO);
    for (int m0 = gw; m0 < TOK; m0 += 2 * NGW) {
        f32x4 v[2][8];
#pragma unroll
        for (int q = 0; q < 2; ++q) ln_load_bf16(v[q], src + (size_t)(m0 + q * NGW) * DM_, lane);
        ln_core2(v[0], v[1], gp, bp, lane, st + 2 * m0, st + 2 * (m0 + NGW));
        float lg[2][8];
#pragma unroll
        for (int q = 0; q < 2; ++q) ln_store_fp8(v[q], (unsigned char*)dstb + (size_t)(m0 + q * NGW) * DM_, lane);
#pragma unroll
        for (int e = 0; e < 8; ++e) { float p0 = 0.f, p1 = 0.f;
#pragma unroll
            for (int j = 0; j < 8; ++j) { const f32x4 r4 = *(const LAS f32x4*)(rwT + e * DM_ + 8 * lane + LN_COL(j));
                p0 += (v[0][j].x * r4.x + v[0][j].y * r4.y) + (v[0][j].z * r4.z + v[0][j].w * r4.w); p1 += (v[1][j].x * r4.x + v[1][j].y * r4.y) + (v[1][j].z * r4.z + v[1][j].w * r4.w); }
            lg[0][e] = wave_sum(p0); lg[1][e] = wave_sum(p1); }
#pragma unroll
        for (int q = 0; q < 2; ++q) { const int m = m0 + q * NGW;
            int e0 = 0; float v0 = lg[q][0];
#pragma unroll
            for (int e = 1; e < 8; ++e) if (lg[q][e] > v0) { v0 = lg[q][e]; e0 = e; }
            int e1 = -1; float v1 = -INFINITY;
#pragma unroll
            for (int e = 0; e < 8; ++e) if (e != e0 && lg[q][e] > v1) { v1 = lg[q][e]; e1 = e; }
            const float w0 = 1.0f / (1.0f + expf(v1 - v0)), w1 = 1.0f - w0;
            if (lane == 0) {
                const unsigned p0 = __hip_atomic_fetch_add((LAS unsigned*)(MISC + 16 + e0), 1u, __ATOMIC_RELAXED, __HIP_MEMORY_SCOPE_WORKGROUP), p1 = __hip_atomic_fetch_add((LAS unsigned*)(MISC + 16 + e1), 1u, __ATOMIC_RELAXED, __HIP_MEMORY_SCOPE_WORKGROUP);
                int4 r0 = make_int4(e0, (int)p0, e1, (int)p1), r1 = make_int4((int)__float_as_uint(w0), (int)__float_as_uint(w1), 0, 0);
                *(int4*)(tokinfo + (size_t)m * 8) = r0; *(int4*)(tokinfo + (size_t)m * 8 + 4) = r1;
            } }
    }
    __syncthreads();
    if (tid < 8) {
        const unsigned n = MISC[16 + tid];
        const unsigned base = __hip_atomic_fetch_add((unsigned*)(ws + WS_CTL) + CW_CNT + 64 * tid, n, __ATOMIC_RELAXED, __HIP_MEMORY_SCOPE_AGENT);
        ((unsigned*)(ws + WS_BBASE))[vcu * 8 + tid] = base;
    }
    __syncthreads();
}
__device__ __forceinline__ void load_cnt(const unsigned char* ws, unsigned (&cnt)[8]) {
#pragma unroll
    for (int e = 0; e < 8; ++e) cnt[e] = (unsigned)__builtin_amdgcn_readfirstlane((int)ld_u32_agent((const unsigned*)(ws + WS_CTL) + CW_CNT + 64 * e));
}
__device__ __forceinline__ void ph_gather(const Args& a, int vcu, int G, int wave, int lane) {
    unsigned char* ws = arg_ws();
    const int gw = vcu * NWAVES + wave, NGW = G * NWAVES;
    unsigned cnt[8]; load_cnt(ws, cnt);
    int off[8]; { int o = 0;
#pragma unroll
        for (int e = 0; e < 8; ++e) { off[e] = o; o += (int)((cnt[e] + 255u) & ~255u); } }
    const int* tokinfo = (const int*)(ws + WS_TOKINFO); const unsigned* bbase = (const unsigned*)(ws + WS_BBASE);
    int* rowmap = (int*)(ws + WS_ROWMAP); float* roww = (float*)(ws + WS_ROWW);
    const unsigned char* Hb = (const unsigned char*)(ws + WS_XB); unsigned char* Xs = (unsigned char*)(ws + WS_XS);
    int bb[8];
#pragma unroll
    for (int e = 0; e < 8; ++e) bb[e] = off[e] + (int)bbase[vcu * 8 + e];
    constexpr int GB = 4;
    for (int tb = gw; tb < TOK; tb += GB * NGW) {
        int4 r0[GB], r1[GB]; v4u x0[GB], x1[GB];
#pragma unroll
        for (int q = 0; q < GB; ++q) { const int t = tb + q * NGW; if (t < TOK) {
            r0[q] = *(const int4*)(tokinfo + (size_t)t * 8); r1[q] = *(const int4*)(tokinfo + (size_t)t * 8 + 4);
            const GAS v4u* sp = (const GAS v4u*)(Hb + (size_t)t * DM_) + lane; x0[q] = sp[0]; x1[q] = sp[64]; } }
#pragma unroll
        for (int q = 0; q < GB; ++q) { const int t = tb + q * NGW; if (t < TOK) {
            const int e0 = r0[q].x, e1 = r0[q].z; int o0 = 0, o1 = 0;
#pragma unroll
            for (int e = 0; e < 8; ++e) { if (e == e0) o0 = bb[e]; if (e == e1) o1 = bb[e]; }
            const int row0 = o0 + r0[q].y, row1 = o1 + r0[q].w;
            GAS v4u* d0 = (GAS v4u*)(Xs + (size_t)row0 * DM_) + lane; GAS v4u* d1 = (GAS v4u*)(Xs + (size_t)row1 * DM_) + lane;
            d0[0] = x0[q]; d0[64] = x1[q]; d1[0] = x0[q]; d1[64] = x1[q];
            if (lane == 0) { rowmap[row0] = 2 * t; roww[row0] = __int_as_float(r1[q].x); rowmap[row1] = 2 * t + 1; roww[row1] = __int_as_float(r1[q].y); } } }
    }
#pragma unroll
    for (int e = 0; e < 8; ++e) {
        const int pend = (int)((cnt[e] + 255u) & ~255u);
        for (int r = (int)cnt[e] + gw; r < pend; r += NGW) {
            const int row = off[e] + r;
            GAS v4u* d = (GAS v4u*)(Xs + (size_t)row * DM_) + lane;
#pragma unroll
            for (int j = 0; j < 2; ++j) d[64 * j] = (v4u){0u, 0u, 0u, 0u};
            if (lane == 0) { rowmap[row] = -1; roww[row] = 0.f; }
        }
    }
}


#ifndef PH_MASK
#define PH_MASK 0xffffffffu
#endif
#define IN(k) (((PH_MASK >> (k)) & 1u) != 0u && lo <= (k) && (k) < hi)
#define SEAM(k) do { if (lo <= (k) && (k) + 1 < hi) xcd_barrier(bar); } while (0)
#ifndef PROBE_REP
#define PROBE_REP -1
#endif
#define ws arg_ws()
#define WIN ((bf16*)(ws + WS_WIN))
#define WCAT ((bf16*)(ws + WS_WCAT))
#define WBP ((bf16*)(ws + WS_WBP))
#define WOUT ((bf16*)(ws + WS_WOUT))
#define POOLB ((bf16*)(ws + WS_POOLB))
#define QKV ((bf16*)(ws + WS_QKV))
#define XB ((bf16*)(ws + WS_XB))
#define STATS(i) ((float*)(ws + WS_STATS) + (size_t)(i) * 2 * TOK)
#define YF ((bf16*)(ws + WS_Y))
#define MG ((bf16*)(ws + WS_MG))
#define MERGED ((bf16*)(ws + WS_MERGED))
#define AO ((bf16*)(ws + WS_AO))
#define ZB ((bf16*)(ws + WS_ZB))
#define PH_IDS int tid_ = threadIdx.x; asm volatile("" : "+v"(tid_)); const int tid = tid_, lane = tid & 63, wave = __builtin_amdgcn_readfirstlane(tid >> 6); (void)tid; (void)lane; (void)wave
template <int L>
__device__ __forceinline__ void layer_phases(const Args& args, LAS unsigned char* lds, unsigned char* lds_raw, volatile LAS unsigned* MISC, const XcdBarrier& bar, int lo, int hi, int vcu, int G) {
    {

        constexpr int pb = 2 + 10 * L;
        if (IN(pb + 0)) { PH_IDS;
            { pg8::Gemm g{XB, WIN + (size_t)L * INW * DM_, DM_, DM_, DM_}; pg8::StaticOrder S; S.init(TOK, 4096, G, (int)blockIdx.x);
              pg8::EpiInProj E{QKV, attn_body::C2, 0, 99, 1.0f};
              pg8::gemm_phase<pg8::EpiInProj, pg8::StaticOrder, true>(lds + RING_OFF, g, S, E); }
            { pg8::Gemm g{(const bf16*)(ws + WS_X8IN), (const bf16*)(ws + WS_WIN + (size_t)L * INW * DM_ * 2 + WIN_F8_OFF), DM_ / 2, DM_ / 2, DM_ / 2}; pg8::StaticOrder S; S.init(TOK, 4096, G, (int)blockIdx.x);
              pg8::EpiInProj E{QKV, 1.0f, 4, 99, 1.0f / (X8_SCALE * W8_SCALE_UP)};
              pg8::gemm_phase<pg8::EpiInProj, pg8::StaticOrder, true, true>(lds + RING_OFF, g, S, E); }
        }
        SEAM(pb + 0);
        if (IN(pb + 1)) { PH_IDS;
            LAS float* tbl = (LAS float*)(lds + ATT_TBL_OFF);
            const float* tab = (const float*)(ws + WS_TAB) + 1024;
            for (int i = tid; i < 1024; i += NWAVES * 64) tbl[i] = ld_f32_agent(tab + i);
            __syncthreads();
            const attn_body::AttnTensors AT{(const attn_body::bf16*)QKV, (const attn_body::bf16*)(QKV + (size_t)TOK * 1024), (const attn_body::bf16*)(QKV + (size_t)2 * TOK * 1024),
                                            (attn_body::bf16*)(ws + WS_O0), (attn_body::bf16*)(ws + WS_O1)};
            constexpr int A8 = (L == 0) ? ATT_CU_PER_XCD_L0 : 32;
            if ((vcu & 31) < A8) attn_body::attn_phase<8>((char*)lds_raw + RING_OFF, AT, vcu >> 5, vcu & 31, A8, (attn_body::lds_fptr)tbl);
            if constexpr (L == 0) conv_pool(lds, MISC, tid);
        }
        SEAM(pb + 1);
        if (IN(pb + 2)) { PH_IDS;
            if constexpr (L == 0) {
                pg8::Gemm g{WBP, POOLB, 1024, 256, 256}; pg8::FoldOrder S{(int)blockIdx.x}; pg8::EpiBf16Plain E{WCAT + 1024, 2048};
                pg8::gemm_phase<pg8::EpiBf16Plain, pg8::FoldOrder, false>(lds + RING_OFF, g, S, E); }
            ph_finalize(args, L, vcu, G, wave, lane); }
        SEAM(pb + 2);
        if (IN(pb + 3)) { PH_IDS;
            const bf16* GA = QKV + (size_t)4 * TOK * 1024; const bf16* GP = QKV + (size_t)6 * TOK * 1024;
            pg8::Gemm g{AO, WCAT + (size_t)L * DM_ * DM_, DM_, DM_, DM_}; pg8::StaticOrder S; S.init(TOK, DM_, G, (int)blockIdx.x);
            pg8::EpiGateFinal E{GP, MERGED}; pg8::HookGateRatio H{GA, GP};
            pg8::gemm_phase<pg8::EpiGateFinal, pg8::StaticOrder, true, false, pg8::HookGateRatio>(lds + RING_OFF, g, S, E, H);
        }
        SEAM(pb + 3);
        if (IN(pb + 4)) { PH_IDS;
            pg8::Gemm g{MERGED, WOUT + (size_t)L * DM_ * DM_, DM_, DM_, DM_}; pg8::StaticOrder S; S.init(TOK, DM_, G, (int)blockIdx.x);
            if constexpr (L == 0) { pg8::EpiRes E{XB, YF, ALPHA};
              pg8::gemm_phase<pg8::EpiRes, pg8::StaticOrder, true>(lds + RING_OFF, g, S, E); }
            else { pg8::EpiResLn E{YF, STATS(1), arg_in(19), arg_in(20), ALPHA, 1.0f};
              pg8::gemm_phase<pg8::EpiResLn, pg8::StaticOrder, true>(lds + RING_OFF, g, S, E); }
        }
        SEAM(pb + 4);
        if constexpr (L == 0) {
            if (IN(pb + 5)) { PH_IDS; ph_ln<0>(YF, nullptr, arg_in(10), arg_in(11), STATS(0), nullptr, nullptr, nullptr, nullptr, (unsigned char*)XB, vcu, G, wave, lane);   }
            SEAM(pb + 5);
            if (IN(pb + 6)) { PH_IDS;
                pg8::Gemm g{XB, (const bf16*)(ws + WS_WGU_D), DM_ / 2, DM_ / 2, DM_ / 2}; pg8::StaticOrder S; S.init(TOK, 2 * FFD, G, (int)blockIdx.x);
                pg8::EpiSwiglu8 E{(unsigned char*)(ws + WS_ACT_D), FFD, 1.0f / (X8_SCALE * W8_SCALE_UP)};
                pg8::gemm_phase<pg8::EpiSwiglu8, pg8::StaticOrder, true, true>(lds + RING_OFF, g, S, E);
            }
            SEAM(pb + 6);
            if (IN(pb + 7)) { PH_IDS;
                pg8::Gemm g{(const bf16*)(ws + WS_ACT_D), (const bf16*)(ws + WS_WD_D), FFD / 2, FFD / 2, FFD / 2}; pg8::StaticOrder S; S.init(TOK, DM_, G, (int)blockIdx.x);
                pg8::EpiResLn E{YF, STATS(0), arg_in(10), arg_in(11), ALPHA, 1.0f / (pg8::ACT8_SCALE * W8_SCALE_UP)};
                pg8::gemm_phase<pg8::EpiResLn, pg8::StaticOrder, true, true>(lds + RING_OFF, g, S, E);
            }
            SEAM(pb + 7);
            if (IN(pb + 8)) { PH_IDS; ph_ln<0>(YF, nullptr, arg_in(19), arg_in(20), STATS(1), nullptr, nullptr, nullptr, XB, (unsigned char*)(ws + WS_X8IN), vcu, G, wave, lane); }
            SEAM(pb + 8);
        } else {
            if (IN(pb + 5)) { PH_IDS; ph_ln_router(args, YF, arg_in(10) + DM_, arg_in(11) + DM_, STATS(2), XB, lds, MISC, vcu, G, wave, lane, tid); }
            SEAM(pb + 5);
            if (IN(pb + 6)) { PH_IDS; ph_gather(args, vcu, G, wave, lane); }
            SEAM(pb + 6);
            if (IN(pb + 7)) { PH_IDS;
                unsigned cnt[8]; load_cnt(ws, cnt);
                pg8::MoeOrder S; S.init(cnt, 2 * FFE / 256, G, (int)blockIdx.x);
                pg8::Gemm g{(const bf16*)(ws + WS_XS), (const bf16*)(ws + WS_WGU_E), DM_ / 2, DM_ / 2, DM_ / 2};
                pg8::EpiSwiglu8 E{(unsigned char*)(ws + WS_ACT_E), FFE, 1.0f / (X8_SCALE * W8_SCALE_UP)};
                pg8::gemm_phase<pg8::EpiSwiglu8, pg8::MoeOrder, true, true>(lds + RING_OFF, g, S, E);
            }
            SEAM(pb + 7);
            if (IN(pb + 8)) { PH_IDS;
                unsigned cnt[8]; load_cnt(ws, cnt);
                pg8::MoeOrder S; S.init(cnt, DM_ / 256, G, (int)blockIdx.x);
                pg8::Gemm g{(const bf16*)(ws + WS_ACT_E), (const bf16*)(ws + WS_WD_E), FFE / 2, FFE / 2, FFE / 2};
                pg8::EpiMoeDown E{(const int*)(ws + WS_ROWMAP), (const float*)(ws + WS_ROWW), (bf16*)(ws + WS_Y2), 1.0f / (pg8::ACT8_SCALE * W8_SCALE_DOWN)};
                pg8::gemm_phase<pg8::EpiMoeDown, pg8::MoeOrder, true, true>(lds + RING_OFF, g, S, E);
            }
            SEAM(pb + 8);
            if (IN(pb + 9)) { PH_IDS; ph_ln<2>(YF, (const bf16*)(ws + WS_Y2), arg_in(19) + DM_, arg_in(20) + DM_, STATS(2), arg_in(10) + DM_, arg_in(11) + DM_, arg_out(), nullptr, nullptr, vcu, G, wave, lane); }
        }

    }
}
__global__ void __launch_bounds__(NWAVES * 64, 2) fwd_kernel(Args args) {
    extern __shared__ __attribute__((aligned(16))) unsigned char lds_raw[];
    LAS unsigned char* lds = (LAS unsigned char*)lds_raw;
    volatile LAS unsigned* MISC = (volatile LAS unsigned*)(lds + MISC_OFF);
    const int G = gridDim.x; const int bx = blockIdx.x; const int vcu = (G % 8 == 0) ? (bx % 8) * (G / 8) + bx / 8 : bx;
    gu32* ctl = (gu32*)(arg_ws() + WS_CTL);
    for (int u = threadIdx.x; u < (LDS_BYTES - LDSCTL_OFF) / 4; u += NWAVES * 64) ((LAS unsigned*)(lds + LDSCTL_OFF))[u] = 0u;
    __syncthreads();
    XcdBarrier bar; bar.bar = (unsigned*)(ctl + CW_BAR); bar.x = 0; bar.st = nullptr;
    if (N_LAUNCHES == 1) bar = xcd_barrier_post((unsigned*)(ctl + CW_BAR), MISC + 8);
    const int lo = args.ph_lo, hi = args.ph_hi;


    if (IN(0)) { PH_IDS; ph_prologue(args, lds, vcu, G, wave, lane, tid); }
    SEAM(0);

    layer_phases<0>(args, lds, lds_raw, MISC, bar, lo, hi, vcu, G);
    layer_phases<1>(args, lds, lds_raw, MISC, bar, lo, hi, vcu, G);
#undef IN
#undef SEAM
}
#undef ws
#undef WIN
#undef WCAT
#undef WBP
#undef WOUT
#undef POOLB
#undef QKV
#undef XB
#undef STATS
#undef YF
#undef MG
#undef MERGED
#undef AO
#undef ZB

extern "C" void kernel_launch(void* const* d_in, const int* in_sizes, int n_in, void* d_out, int out_size, void* d_ws, size_t ws_size, hipStream_t stream) {
    static int grid = 0;
    if (grid == 0) {
        if (n_in != 21 || in_sizes[0] != TOK * DM_ || out_size != TOK * DM_ || ws_size < WS_END) { fprintf(stderr, "kernel_launch: unexpected shapes / workspace (n_in %d, ws %zu < %zu); nothing launched\n", n_in, ws_size, (size_t)WS_END); grid = -1; return; }
        int dev = 0, cus = 0, per_cu = 0;
        if (hipGetDevice(&dev) != hipSuccess || hipDeviceGetAttribute(&cus, hipDeviceAttributeMultiprocessorCount, dev) != hipSuccess) { grid = -1; return; }
        if (hipFuncSetAttribute((const void*)fwd_kernel, hipFuncAttributeMaxDynamicSharedMemorySize, LDS_BYTES) != hipSuccess) { fprintf(stderr, "kernel_launch: hipFuncSetAttribute failed\n"); grid = -1; return; }
        if (hipOccupancyMaxActiveBlocksPerMultiprocessor(&per_cu, (const void*)fwd_kernel, NWAVES * 64, LDS_BYTES) != hipSuccess || per_cu < 1)
            fprintf(stderr, "kernel_launch: note: occupancy query reports %d workgroups per CU\n", per_cu);
        (void)hipGetLastError();
        grid = cus;
    }
    if (grid < 0) return;
    if (hipMemsetAsync((char*)d_ws + WS_CTL, 0, CTL_ZERO_BYTES, stream) != hipSuccess) return;
    Args a{};
    for (int i = 0; i < 21; ++i) a.in[i] = (const float*)d_in[i];
    a.out = (float*)d_out; a.ws = (unsigned char*)d_ws;
    for (int li = 0; li < N_LAUNCHES; ++li) {
        a.ph_lo = (N_LAUNCHES == 1) ? 0 : li; a.ph_hi = (N_LAUNCHES == 1) ? NPHASE : li + 1;
        hipLaunchKernelGGL(fwd_kernel, dim3(grid), dim3(NWAVES * 64), LDS_BYTES, stream, a);
        const hipError_t le = hipPeekAtLastError();
        if (le != hipSuccess) { fprintf(stderr, "kernel_launch: launch %d failed: %s\n", li, hipGetErrorName(le)); break; }
    }
}
```

```cpp
#include <hip/hip_runtime.h>
#include <hip/hip_bf16.h>
#include <cstdio>
#include <cstdint>
#include <cmath>

constexpr int BATCH = 2, SEQ = 8192, TOK = BATCH * SEQ, DM_ = 2048;
constexpr int AW = 1024, PW = 1024, INW = 8192;
constexpr int FFD = 5632, NEXP = 8, FFE = 7168;
constexpr float LN_EPS = 1e-5f;
constexpr float ALPHA = 1.41421356237309515f;

struct Args { const float* in[21]; float* out; unsigned char* ws; int ph_lo, ph_hi; };
#define KAS __attribute__((address_space(4)))
typedef const KAS unsigned char* kargp_t;
__device__ __forceinline__ kargp_t karg() { kargp_t p = (kargp_t)__builtin_amdgcn_kernarg_segment_ptr(); asm volatile("" : "+s"(p)); return p; }
__device__ __forceinline__ const float* arg_in(int k) { return *(const float* const KAS*)(karg() + 8 * k); }
__device__ __forceinline__ float* arg_out() { return *(float* const KAS*)(karg() + 8 * 21); }
__device__ __forceinline__ unsigned char* arg_ws() { return *(unsigned char* const KAS*)(karg() + 8 * 22); }
static_assert(sizeof(Args) == 192, "Args layout");

namespace pg8 {
#define PG8_LAS __attribute__((address_space(3)))
typedef unsigned short bf16_t;
typedef short bf16x8 __attribute__((ext_vector_type(8)));
typedef float f32x4 __attribute__((ext_vector_type(4)));
typedef unsigned u32x4 __attribute__((ext_vector_type(4)));
typedef unsigned u32x2 __attribute__((ext_vector_type(2)));
constexpr int BM = 256, BK = 64, HALF = 128, HTB = HALF * BK * 2  , STAGE_BYTES = 8 * HTB, NXCD = 8, WGM = 8;

__host__ __device__ __forceinline__ int lds_byte(int r, int c) { const int st = (r >> 4) * 2 + (c >> 5), rr = r & 15, cc = c & 31, ob = rr * 64 + cc * 2; return st * 1024 + (ob ^ (((ob >> 9) & 1) << 5)); }
__host__ __device__ __forceinline__ void stage_rc(int b, int& R, int& C) { const int st = b / 1024, sb = b % 1024, swz = sb ^ (((sb >> 9) & 1) << 5); R = (st >> 1) * 16 + swz / 64; C = (st & 1) * 32 + (swz % 64) / 2; }
__host__ __device__ __forceinline__ int perm32(int rho) { const int n = rho >> 4, i = rho & 15; return 8 * (i >> 2) + 4 * n + (i & 3); }

struct Unit { int pm, pn, pb, ka; };
struct Gemm { const bf16_t* A; const bf16_t* Bt; int lda, ldb, K; };

struct StaticOrder {
    int nM, nN, nwg, G, c;
    __host__ __device__ void init(int M, int N, int G_, int c_) { nM = M / BM; nN = N / BM; nwg = nM * nN; G = G_; c = c_; }
    __host__ __device__ bool next(int i, Unit& u) const {
        const long L = (long)i * G + c; if (L >= nwg) return false;
        int wgid = (int)L; { const int q = nwg / NXCD, r = nwg % NXCD, xcd = wgid % NXCD, off = wgid / NXCD; wgid = (xcd < r ? xcd * (q + 1) : r * (q + 1) + (xcd - r) * q) + off; }
        const int nig = WGM * nN, gid = wgid / nig, fm = gid * WGM, gsz = (nM - fm) < WGM ? (nM - fm) : WGM;
        u.pm = fm + ((wgid % nig) % gsz); u.pn = (wgid % nig) / gsz; u.pb = u.pn; u.ka = 0; return true;
    }
    __device__ __forceinline__ void a_ready(const Unit&) const {}
    __device__ __forceinline__ void done(const Unit&) const {}
};
struct FoldOrder {
    int c;
    __device__ bool next(int i, Unit& u) const {
        if (i > 0 || c >= 64) return false;
        const int l = c >> 5, g = (c >> 3) & 3, pm = c & 7;
        u.pm = l * 8 + pm; u.pn = g; u.pb = l * 4 + g; u.ka = 256 * g; return true;
    }
    __device__ __forceinline__ void a_ready(const Unit&) const {}
    __device__ __forceinline__ void done(const Unit&) const {}
};
struct MoeOrder {
    int nN, G, c, nwg;
    int n0, n1, n2, n3, n4, n5, n6, n7;
    __device__ __forceinline__ void init(const unsigned (&cnt)[8], int nN_, int G_, int c_) {
        nN = nN_; G = G_; c = c_;
        n0 = (int)((cnt[0] + 255u) >> 8); n1 = (int)((cnt[1] + 255u) >> 8); n2 = (int)((cnt[2] + 255u) >> 8); n3 = (int)((cnt[3] + 255u) >> 8);
        n4 = (int)((cnt[4] + 255u) >> 8); n5 = (int)((cnt[5] + 255u) >> 8); n6 = (int)((cnt[6] + 255u) >> 8); n7 = (int)((cnt[7] + 255u) >> 8);
        nwg = (n0 + n1 + n2 + n3 + n4 + n5 + n6 + n7) * nN_;
    }
    __device__ __forceinline__ bool next(int i, Unit& u) const { const long L = (long)i * G + c; if (L >= nwg) return false; return decode((int)L, u); }
    __device__ __forceinline__ bool decode(int wgid, Unit& u) const {
        { const int q = nwg / NXCD, r = nwg % NXCD, xcd = wgid % NXCD, off = wgid / NXCD; wgid = (xcd < r ? xcd * (q + 1) : r * (q + 1) + (xcd - r) * q) + off; }
        int e = 0, nte = n0, to = 0, pt = n0;
#define MOE_STEP(k, nk) do { if (wgid >= pt * nN) { e = (k); nte = (nk); to = pt; } pt += (nk); } while (0)
        MOE_STEP(1, n1); MOE_STEP(2, n2); MOE_STEP(3, n3); MOE_STEP(4, n4); MOE_STEP(5, n5); MOE_STEP(6, n6); MOE_STEP(7, n7);
#undef MOE_STEP
        const int rem = wgid - to * nN, nig = WGM * nN, gid = rem / nig, fm = gid * WGM, gsz = (nte - fm) < WGM ? (nte - fm) : WGM;
        const int w = rem % nig;
        u.pm = to + fm + (w % gsz); u.pn = w / gsz; u.pb = e * nN + u.pn; u.ka = 0; return true;
    }
    __device__ __forceinline__ void a_ready(const Unit&) const {}
    __device__ __forceinline__ void done(const Unit&) const {}
};

struct MoeUpOrder {
    int G, c, nwg, aA, nB; MoeOrder T; unsigned* panel; mutable int pend;
    __device__ __forceinline__ void init(const unsigned (&cnt)[8], int G_, int c_, unsigned* panel_) {
        G = G_; c = c_; panel = panel_; pend = -1; T.init(cnt, 56, G_, c_); nwg = T.nwg;
        const int nwg_dn = (nwg / 56) * 8, rd = (nwg_dn + G_ - 1) / G_, nlast = nwg_dn - (rd - 1) * G_;
        const int nA = nlast < G_ ? ((nlast + 7) & ~7) : 0;
        nB = G_ - nA; if (nB < 8) nB = G_;
        aA = (nwg - nB * 3) / G_; if (aA < 0) aA = 0;
    }
    __device__ __forceinline__ bool next(int i, Unit& u) const {
        long L; if (i < aA) L = (long)i * G + c; else { if (c >= nB) return false; L = (long)aA * G + (long)(i - aA) * nB + c; }
        if (L >= nwg) return false; return T.decode((int)L, u);
    }
    __device__ __forceinline__ void a_ready(const Unit&) const {}
    __device__ __forceinline__ void done(const Unit& u) const {
        if (pend >= 0 && (threadIdx.x & 63) == 0) __hip_atomic_fetch_add(panel + 64 * pend, 1u, __ATOMIC_RELAXED, __HIP_MEMORY_SCOPE_AGENT);
        pend = u.pm;
    }
    __device__ __forceinline__ void flush() const {
        asm volatile("s_waitcnt vmcnt(0)" ::: "memory");
        if (pend >= 0 && (threadIdx.x & 63) == 0) __hip_atomic_fetch_add(panel + 64 * pend, 1u, __ATOMIC_RELAXED, __HIP_MEMORY_SCOPE_AGENT);
        pend = -1;
    }
};
struct MoeDownOrder {
    int G, cr; MoeOrder T; const unsigned* panel; unsigned* tmo;
    __device__ __forceinline__ void init(const unsigned (&cnt)[8], int G_, int c_, const unsigned* panel_, unsigned* tmo_) { G = G_; cr = G_ - 1 - c_; panel = panel_; tmo = tmo_; T.init(cnt, 8, G_, cr); }
    __device__ __forceinline__ bool next(int i, Unit& u) const { const long L = (long)i * G + cr; if (L >= T.nwg) return false; return T.decode((int)L, u); }
    __device__ __forceinline__ void a_ready(const Unit& u) const {
        if (threadIdx.x < 64) {
            const unsigned long long t0 = __builtin_amdgcn_s_memrealtime(); unsigned polls = 0;
            while ((unsigned)__builtin_amdgcn_readfirstlane(__hip_atomic_load(panel + 64 * u.pm, __ATOMIC_RELAXED, __HIP_MEMORY_SCOPE_AGENT)) < 448u) {
                if ((++polls & 255u) == 0u && __builtin_amdgcn_readfirstlane(__hip_atomic_load(tmo, __ATOMIC_RELAXED, __HIP_MEMORY_SCOPE_AGENT)) != 0u) break;
                if (__builtin_amdgcn_s_memrealtime() - t0 > 2000000ull) {
                    if (threadIdx.x == 0) { unsigned expect = 0u; __hip_atomic_compare_exchange_strong(tmo + 1, &expect, 0x600u | (unsigned)(u.pm & 0xff), __ATOMIC_RELAXED, __ATOMIC_RELAXED, __HIP_MEMORY_SCOPE_AGENT); __hip_atomic_store(tmo, 1u, __ATOMIC_RELAXED, __HIP_MEMORY_SCOPE_AGENT); }
                    break; }
                __builtin_amdgcn_s_sleep(2); }
            __builtin_amdgcn_fence(__ATOMIC_ACQUIRE, "agent");
            asm volatile("s_waitcnt vmcnt(0)" ::: "memory");
        }
        asm volatile("" ::: "memory"); __builtin_amdgcn_s_barrier(); asm volatile("" ::: "memory");
    }
    __device__ __forceinline__ void done(const Unit&) const {}
};

__device__ __forceinline__ unsigned cvt_pk_bf16(float lo, float hi) { unsigned r; asm volatile("v_cvt_pk_bf16_f32 %0, %1, %2" : "=v"(r) : "v"(lo), "v"(hi)); return r; }
__device__ __forceinline__ float sigm(float x) { return __builtin_amdgcn_rcpf(1.0f + __builtin_amdgcn_exp2f(-1.4426950408889634f * x)); }
__device__ __forceinline__ float bflo(unsigned w) { return __uint_as_float(w << 16); }
__device__ __forceinline__ float bfhi(unsigned w) { return __uint_as_float(w & 0xffff0000u); }
__device__ __forceinline__ u32x4 pack8(const f32x4 v0, const f32x4 v1) { u32x4 w; w.x = cvt_pk_bf16(v0[0], v0[1]); w.y = cvt_pk_bf16(v0[2], v0[3]); w.z = cvt_pk_bf16(v1[0], v1[1]); w.w = cvt_pk_bf16(v1[2], v1[3]); return w; }

struct EpiInProj {
    static constexpr bool PERM = true, AFTER_DRAIN = false;
    bf16_t* O; float scale0; int comp, tplain; float s;
    __device__ __forceinline__ void operator()(const f32x4 (&acc)[2][2][4][2], const Unit& u, int wr, int wc, int fr, int fq) const {
        const int row0 = u.pm * BM + wr * 64 + fr; const int ct = u.pn * BM; const bool split = ct < 1024;
        const int t = split ? (ct >> 9) : tplain + ((ct - 1024) >> 10);
        const float s0 = (t == 0) ? s * scale0 : s;
        bf16_t* base = O + (size_t)t * ((size_t)TOK * 1024);
        const int j0 = (split ? (ct & 511) : ((ct - 1024) & 1023)) + wc * 32 + 8 * fq;
#pragma unroll
        for (int ai = 0; ai < 2; ++ai)
#pragma unroll
            for (int m = 0; m < 4; ++m) { bf16_t* rowp = base + (size_t)(row0 + ai * HALF + m * 16) * 1024;
#pragma unroll
                for (int bj = 0; bj < 2; ++bj) { f32x4 v0 = acc[ai][bj][m][0], v1 = acc[ai][bj][m][1];
                    v0 = v0 * s0; v1 = v1 * s0;
                    if (t >= 4) {
#pragma unroll
                        for (int k = 0; k < 4; ++k) { v0[k] = sigm(v0[k]); v1[k] = sigm(v1[k]); } }
                    const int j = j0 + bj * HALF; const int oc = split ? (((j >> 6) << 7) + comp * 64 + (j & 63)) : j;
                    *(u32x4*)(rowp + oc) = pack8(v0, v1); } }
    }
};
struct EpiBf16Plain {
    static constexpr bool PERM = true, AFTER_DRAIN = false;
    bf16_t* O; int ldc;
    __device__ __forceinline__ void operator()(const f32x4 (&acc)[2][2][4][2], const Unit& u, int wr, int wc, int fr, int fq) const {
        const int row0 = u.pm * BM + wr * 64 + fr; const int col0 = u.pn * BM + wc * 32 + 8 * fq;
#pragma unroll
        for (int ai = 0; ai < 2; ++ai)
#pragma unroll
            for (int m = 0; m < 4; ++m) { bf16_t* rowp = O + (size_t)(row0 + ai * HALF + m * 16) * ldc + col0;
#pragma unroll
                for (int bj = 0; bj < 2; ++bj) *(u32x4*)(rowp + bj * HALF) = pack8(acc[ai][bj][m][0], acc[ai][bj][m][1]); }
    }
};
struct HookGateRatio {
    static constexpr bool ENABLED = true;
    const bf16_t* Ga; const bf16_t* Gp;
    __device__ __forceinline__ void operator()(f32x4 (&acc)[2][2][4][2], const Unit& u, int wr, int wc, int fr, int fq) const {
        const int row0 = u.pm * BM + wr * 64 + fr; const int ct = u.pn * BM;
        const size_t go = (size_t)(ct >> 10) * ((size_t)TOK * 1024) + (ct & 1023) + wc * 32 + 8 * fq;
#pragma unroll
        for (int ai = 0; ai < 2; ++ai) {
            u32x4 a[4][2], p[4][2];
#pragma unroll
            for (int m = 0; m < 4; ++m)
#pragma unroll
                for (int bj = 0; bj < 2; ++bj) { const size_t o = go + (size_t)(row0 + ai * HALF + m * 16) * 1024 + bj * HALF; a[m][bj] = *(const u32x4*)(Ga + o); p[m][bj] = *(const u32x4*)(Gp + o); }
#pragma unroll
            for (int m = 0; m < 4; ++m)
#pragma unroll
                for (int bj = 0; bj < 2; ++bj) { const u32x4 x = a[m][bj], y = p[m][bj];
                    const f32x4 r0 = {bflo(x.x) * __builtin_amdgcn_rcpf(bflo(y.x)), bfhi(x.x) * __builtin_amdgcn_rcpf(bfhi(y.x)), bflo(x.y) * __builtin_amdgcn_rcpf(bflo(y.y)), bfhi(x.y) * __builtin_amdgcn_rcpf(bfhi(y.y))};
                    const f32x4 r1 = {bflo(x.z) * __builtin_amdgcn_rcpf(bflo(y.z)), bfhi(x.z) * __builtin_amdgcn_rcpf(bfhi(y.z)), bflo(x.w) * __builtin_amdgcn_rcpf(bflo(y.w)), bfhi(x.w) * __builtin_amdgcn_rcpf(bfhi(y.w))};
                    acc[ai][bj][m][0] = acc[ai][bj][m][0] * r0; acc[ai][bj][m][1] = acc[ai][bj][m][1] * r1; }
            asm volatile("" ::: "memory");
        }
    }
};
struct NoHook { static constexpr bool ENABLED = false; __device__ __forceinline__ void operator()(f32x4 (&)[2][2][4][2], const Unit&, int, int, int, int) const {} };
struct EpiGateFinal {
    static constexpr bool PERM = true, AFTER_DRAIN = false;
    const bf16_t* Gp; bf16_t* Out;
    __device__ __forceinline__ void operator()(const f32x4 (&acc)[2][2][4][2], const Unit& u, int wr, int wc, int fr, int fq) const {
        const int row0 = u.pm * BM + wr * 64 + fr; const int ct = u.pn * BM;
        const bf16_t* gb = Gp + (size_t)(ct >> 10) * ((size_t)TOK * 1024) + (ct & 1023) + wc * 32 + 8 * fq;
        const int col0 = ct + wc * 32 + 8 * fq;
#pragma unroll
        for (int ai = 0; ai < 2; ++ai)
#pragma unroll
            for (int m = 0; m < 4; ++m) { const int r = row0 + ai * HALF + m * 16;
#pragma unroll
                for (int bj = 0; bj < 2; ++bj) { const u32x4 g = *(const u32x4*)(gb + (size_t)r * 1024 + bj * HALF);
                    const f32x4 g0 = {bflo(g.x), bfhi(g.x), bflo(g.y), bfhi(g.y)}, g1 = {bflo(g.z), bfhi(g.z), bflo(g.w), bfhi(g.w)};
                    *(u32x4*)(Out + (size_t)r * DM_ + col0 + bj * HALF) = pack8(acc[ai][bj][m][0] * g0, acc[ai][bj][m][1] * g1); } }
    }
};
struct EpiRes {
    static constexpr bool PERM = true, AFTER_DRAIN = false;
    const bf16_t* base; bf16_t* out; float alpha;
    __device__ __forceinline__ void operator()(const f32x4 (&acc)[2][2][4][2], const Unit& u, int wr, int wc, int fr, int fq) const {
        const int row0 = u.pm * BM + wr * 64 + fr; const int col0 = u.pn * BM + wc * 32 + 8 * fq;
#pragma unroll
        for (int ai = 0; ai < 2; ++ai)
#pragma unroll
            for (int m = 0; m < 4; ++m) { const size_t ro = (size_t)(row0 + ai * HALF + m * 16) * DM_ + col0;
#pragma unroll
                for (int bj = 0; bj < 2; ++bj) { const u32x4 b = *(const u32x4*)(base + ro + bj * HALF);
                    const f32x4 b0 = {bflo(b.x), bfhi(b.x), bflo(b.y), bfhi(b.y)}, b1 = {bflo(b.z), bfhi(b.z), bflo(b.w), bfhi(b.w)};
                    *(u32x4*)(out + ro + bj * HALF) = pack8(b0 * alpha + acc[ai][bj][m][0], b1 * alpha + acc[ai][bj][m][1]); } }
    }
};
struct EpiResLn {
    static constexpr bool PERM = true, AFTER_DRAIN = false;
    bf16_t* Y; const float* st; const float* gp; const float* bp; float alpha; float s;
    __device__ __forceinline__ void operator()(const f32x4 (&acc)[2][2][4][2], const Unit& u, int wr, int wc, int fr, int fq) const {
        const int row0 = u.pm * BM + wr * 64 + fr; const int col0 = u.pn * BM + wc * 32 + 8 * fq;
        f32x4 gv[2][2], bv[2][2];
#pragma unroll
        for (int bj = 0; bj < 2; ++bj)
#pragma unroll
            for (int n = 0; n < 2; ++n) { gv[bj][n] = *(const f32x4*)(gp + col0 + bj * HALF + n * 4); bv[bj][n] = *(const f32x4*)(bp + col0 + bj * HALF + n * 4); }
#pragma unroll
        for (int ai = 0; ai < 2; ++ai)
#pragma unroll
            for (int m = 0; m < 4; ++m) { const int r = row0 + ai * HALF + m * 16; const float mu = st[2 * r], rs = st[2 * r + 1]; bf16_t* yr = Y + (size_t)r * DM_ + col0;
#pragma unroll
                for (int bj = 0; bj < 2; ++bj) { const u32x4 y = *(const u32x4*)(yr + bj * HALF);
                    const f32x4 y0 = {bflo(y.x), bfhi(y.x), bflo(y.y), bfhi(y.y)}, y1 = {bflo(y.z), bfhi(y.z), bflo(y.w), bfhi(y.w)};
                    const f32x4 h0 = (y0 - mu) * rs * gv[bj][0] + bv[bj][0], h1 = (y1 - mu) * rs * gv[bj][1] + bv[bj][1];
                    *(u32x4*)(yr + bj * HALF) = pack8(h0 * alpha + acc[ai][bj][m][0] * s, h1 * alpha + acc[ai][bj][m][1] * s); } }
    }
};
struct EpiSwiglu {
    static constexpr bool PERM = true, AFTER_DRAIN = false;
    bf16_t* O; int ldo; float s;
    __device__ __forceinline__ void operator()(const f32x4 (&acc)[2][2][4][2], const Unit& u, int wr, int wc, int fr, int fq) const {
        const int row0 = u.pm * BM + wr * 64 + fr; const int col0 = u.pn * HALF + wc * 32 + 8 * fq;
#pragma unroll
        for (int ai = 0; ai < 2; ++ai)
#pragma unroll
            for (int m = 0; m < 4; ++m) { f32x4 h0, h1;
#pragma unroll
                for (int k = 0; k < 4; ++k) { const float g0 = acc[ai][0][m][0][k] * s, g1 = acc[ai][0][m][1][k] * s;
                    h0[k] = g0 * sigm(g0) * (acc[ai][1][m][0][k] * s); h1[k] = g1 * sigm(g1) * (acc[ai][1][m][1][k] * s); }
                *(u32x4*)(O + (size_t)(row0 + ai * HALF + m * 16) * ldo + col0) = pack8(h0, h1); }
    }
};
__device__ __forceinline__ unsigned pk4_fp8(float a, float b, float c, float d) { int w = __builtin_amdgcn_cvt_pk_fp8_f32(a, b, 0, false); w = __builtin_amdgcn_cvt_pk_fp8_f32(c, d, w, true); return (unsigned)w; }
__device__ __forceinline__ float clamp448(float x) { return __builtin_fminf(__builtin_fmaxf(x, -448.0f), 448.0f); }
constexpr float ACT8_SCALE = 4.0f;
template <bool WT = false>
struct EpiSwiglu8 {
    static constexpr bool PERM = true, AFTER_DRAIN = false;
    unsigned char* Ob; int ldo; float s;
    __device__ __forceinline__ void operator()(const f32x4 (&acc)[2][2][4][2], const Unit& u, int wr, int wc, int fr, int fq) const {
        unsigned char* const O = Ob + (size_t)u.pm * BM * ldo + u.pn * HALF;
        const unsigned off0 = (unsigned)((wr * 64 + fr) * ldo + wc * 32 + 8 * fq); const float su = s * ACT8_SCALE;
#pragma unroll
        for (int ai = 0; ai < 2; ++ai)
#pragma unroll
            for (int m = 0; m < 4; ++m) { f32x4 h0, h1;
#pragma unroll
                for (int k = 0; k < 4; ++k) { const float g0 = acc[ai][0][m][0][k] * s, g1 = acc[ai][0][m][1][k] * s;
                    h0[k] = clamp448(g0 * sigm(g0) * (acc[ai][1][m][0][k] * su)); h1[k] = clamp448(g1 * sigm(g1) * (acc[ai][1][m][1][k] * su)); }
                u32x2 w; w.x = pk4_fp8(h0[0], h0[1], h0[2], h0[3]); w.y = pk4_fp8(h1[0], h1[1], h1[2], h1[3]);
                if constexpr (WT) __hip_atomic_store((unsigned long long*)(O + (off0 + (unsigned)((ai * HALF + m * 16) * ldo))), (unsigned long long)w.x | ((unsigned long long)w.y << 32), __ATOMIC_RELAXED, __HIP_MEMORY_SCOPE_AGENT);
                else *(u32x2*)(O + (off0 + (unsigned)((ai * HALF + m * 16) * ldo))) = w; }
    }
};
struct EpiMoeDown {
    static constexpr bool PERM = true, AFTER_DRAIN = false;
    const int* rowmap; const float* roww; bf16_t* Y2; float s;
    __device__ __forceinline__ void operator()(const f32x4 (&acc)[2][2][4][2], const Unit& u, int wr, int wc, int fr, int fq) const {
        const int row0 = u.pm * BM + wr * 64 + fr; const int col0 = u.pn * BM + wc * 32 + 8 * fq;
#pragma unroll
        for (int ai = 0; ai < 2; ++ai)
#pragma unroll
            for (int m = 0; m < 4; ++m) { const int r = row0 + ai * HALF + m * 16; const int tm = rowmap[r];
                if (tm >= 0) { const float w = roww[r] * s; bf16_t* o = Y2 + (size_t)tm * DM_ + col0;
#pragma unroll
                    for (int bj = 0; bj < 2; ++bj) *(u32x4*)(o + bj * HALF) = pack8(acc[ai][bj][m][0] * w, acc[ai][bj][m][1] * w); } }
    }
};

__device__ __forceinline__ void glds16s(const char* sbase, unsigned voff, unsigned lds_dst) { unsigned keep;
    asm volatile("s_mov_b32 %0, m0\n\ts_mov_b32 m0, %3\n\ts_nop 0\n\tglobal_load_lds_dwordx4 %1, %2\n\ts_mov_b32 m0, %0" : "=&s"(keep) : "v"(voff), "s"(sbase), "s"(lds_dst) : "memory"); }
typedef int v8i_t __attribute__((ext_vector_type(8)));
typedef int v4i_t __attribute__((ext_vector_type(4)));
__device__ __forceinline__ v8i_t cat8(bf16x8 a, bf16x8 b) { const v4i_t x = __builtin_bit_cast(v4i_t, a), y = __builtin_bit_cast(v4i_t, b); return __builtin_shufflevector(x, y, 0, 1, 2, 3, 4, 5, 6, 7); }
template <class Epi, class Sched, bool ALIGN_EPI = false, bool F8 = false, class Hook = NoHook>
__device__ __forceinline__ void gemm_phase(PG8_LAS unsigned char* lds, const Gemm g, const Sched& S, const Epi& E, const Hook& H = Hook()) {
    int tid_ = threadIdx.x; asm volatile("" : "+v"(tid_));
    const int tid = tid_, wid = __builtin_amdgcn_readfirstlane(tid >> 6), lane = tid & 63, wr = wid >> 2, wc = wid & 3, fr = lane & 15, fq = lane >> 4;
    const int K = g.K, nt = K / BK;
    unsigned voffA[2], voffB[2];
#pragma unroll
    for (int i = 0; i < 2; ++i) { int R, C; stage_rc(tid * 16 + i * 8192, R, C); const int Rb = Epi::PERM ? ((R & ~31) + perm32(R & 31)) : R;
        voffA[i] = (unsigned)(R * g.lda + C) * 2u; voffB[i] = (unsigned)(Rb * g.ldb + C) * 2u; }
    const size_t kstep = (size_t)(BK * 2);
    const size_t hstepA = (size_t)HALF * g.lda * 2, hstepB = (size_t)HALF * g.ldb * 2;
    const unsigned ldsb = (unsigned)__builtin_amdgcn_readfirstlane((int)((unsigned)(size_t)lds + (unsigned)wid * 1024u));
    unsigned a_addr = (unsigned)(size_t)lds + (unsigned)lds_byte(wr * 64 + fr, fq * 8), b_addr = (unsigned)(size_t)lds + (unsigned)(4 * HTB + lds_byte(wc * 32 + fr, fq * 8)); asm volatile("" : "+v"(a_addr), "+v"(b_addr));
#define PG8_SA(b, h) (((b) * 2 + (h)) * HTB)
#define PG8_SB(b, h) ((4 + (b) * 2 + (h)) * HTB)
#define PG8_STAGE(bufoff, gbase, voff) do { _Pragma("unroll") for (int _i = 0; _i < 2; ++_i) glds16s((const char*)(gbase), (voff)[_i], ldsb + (unsigned)((bufoff) + _i * 8192)); } while (0)
#define PG8_LDA(dst, b, h) do { _Pragma("unroll") for (int m = 0; m < 4; ++m) _Pragma("unroll") for (int k = 0; k < 2; ++k) dst[m][k] = *(const PG8_LAS bf16x8*)(size_t)(a_addr + (unsigned)(PG8_SA(b, h) + m * 2048 + k * 1024)); } while (0)
#define PG8_LDB(dst, b, h) do { _Pragma("unroll") for (int n = 0; n < 2; ++n) _Pragma("unroll") for (int k = 0; k < 2; ++k) dst[n][k] = *(const PG8_LAS bf16x8*)(size_t)(b_addr + (unsigned)(PG8_SB(b, h) - 4 * HTB + n * 2048 + k * 1024)); } while (0)
#define PG8_MMA(ai, bj, At, Bt) do { __builtin_amdgcn_s_setprio(1); _Pragma("unroll") for (int m = 0; m < 4; ++m) _Pragma("unroll") for (int n = 0; n < 2; ++n) { \
        if constexpr (F8) acc[ai][bj][m][n] = __builtin_amdgcn_mfma_scale_f32_16x16x128_f8f6f4(cat8(Bt[n][0], Bt[n][1]), cat8(At[m][0], At[m][1]), acc[ai][bj][m][n], 0, 0, 0, 0, 0, 0);     \
        else { _Pragma("unroll") for (int k = 0; k < 2; ++k) acc[ai][bj][m][n] = __builtin_amdgcn_mfma_f32_16x16x32_bf16(Bt[n][k], At[m][k], acc[ai][bj][m][n], 0, 0, 0); } } \
        __builtin_amdgcn_s_setprio(0); } while (0)
#define PG8_WAIT_V(n) asm volatile("s_waitcnt vmcnt(" #n ")" ::: "memory")
#define PG8_WAIT_L(n) asm volatile("s_waitcnt lgkmcnt(" #n ")" ::: "memory")
#define PG8_BAR __builtin_amdgcn_s_barrier()
#define PG8_SCHED __builtin_amdgcn_sched_barrier(0)
    Unit cur, nxt; int ui = 0;
    if (!S.next(0, cur)) return;
    f32x4 acc[2][2][4][2];
#pragma unroll
    for (int a = 0; a < 2; ++a)
#pragma unroll
        for (int b = 0; b < 2; ++b)
#pragma unroll
            for (int m = 0; m < 4; ++m)
#pragma unroll
                for (int n = 0; n < 2; ++n) acc[a][b][m][n] = (f32x4){0.f, 0.f, 0.f, 0.f};
    bf16x8 At[4][2], B0[2][2], B1[2][2];
    const char* cA = (const char*)g.A + (size_t)cur.pm * 2 * hstepA + (size_t)cur.ka * 2; const char* cB = (const char*)g.Bt + (size_t)cur.pb * 2 * hstepB;
    S.a_ready(cur);
    PG8_STAGE(PG8_SB(0, 0), cB, voffB); PG8_STAGE(PG8_SB(0, 1), cB + hstepB, voffB); PG8_STAGE(PG8_SA(0, 0), cA, voffA); PG8_STAGE(PG8_SA(0, 1), cA + hstepA, voffA);
    if (wr == 1) PG8_BAR;
    PG8_WAIT_V(2); PG8_BAR;
    PG8_STAGE(PG8_SB(1, 0), cB + kstep, voffB); PG8_STAGE(PG8_SA(1, 0), cA + kstep, voffA); PG8_STAGE(PG8_SB(1, 1), cB + hstepB + kstep, voffB);
    PG8_WAIT_V(6); PG8_BAR;
    for (;;) {
        const bool has_next = S.next(ui + 1, nxt);
        const char* nA = has_next ? (const char*)g.A + (size_t)nxt.pm * 2 * hstepA + (size_t)nxt.ka * 2 : cA; const char* nB = has_next ? (const char*)g.Bt + (size_t)nxt.pb * 2 * hstepB : cB;
        for (int t = 0; t < nt; t += 2) {
            const bool last = (t == nt - 2);
            const char* a1 = cA + (size_t)(t + 1) * kstep;
            const char* a2 = last ? nA : cA + (size_t)(t + 2) * kstep; const char* b2 = last ? nB : cB + (size_t)(t + 2) * kstep;
            const char* a3 = a2 + kstep; const char* b3 = b2 + kstep;
            if (last && has_next) S.a_ready(nxt);
            if constexpr (Hook::ENABLED) { if (t == nt / 2) {
                int t3 = threadIdx.x; asm volatile("" : "+v"(t3)); const int w3 = __builtin_amdgcn_readfirstlane(t3 >> 6), l3 = t3 & 63; H(acc, cur, w3 >> 2, w3 & 3, l3 & 15, l3 >> 4); } }
            PG8_LDB(B0, 0, 0); PG8_LDB(B1, 0, 1); PG8_SCHED; PG8_LDA(At, 0, 0); PG8_STAGE(PG8_SA(1, 1), a1 + hstepA, voffA);
            PG8_WAIT_V(8); PG8_WAIT_L(0); PG8_BAR; PG8_MMA(0, 0, At, B0); PG8_MMA(0, 1, At, B1); PG8_BAR; PG8_SCHED;
            PG8_LDA(At, 0, 1); PG8_STAGE(PG8_SB(0, 0), b2, voffB); PG8_STAGE(PG8_SB(0, 1), b2 + hstepB, voffB); PG8_STAGE(PG8_SA(0, 0), a2, voffA);
            PG8_WAIT_V(8); PG8_WAIT_L(0); PG8_BAR; PG8_MMA(1, 0, At, B0); PG8_MMA(1, 1, At, B1); PG8_BAR; PG8_SCHED;
            PG8_LDB(B0, 1, 0); PG8_LDB(B1, 1, 1); PG8_SCHED; PG8_LDA(At, 1, 0); PG8_STAGE(PG8_SA(0, 1), a2 + hstepA, voffA);
            PG8_WAIT_V(8); PG8_WAIT_L(0); PG8_BAR; PG8_MMA(0, 0, At, B0); PG8_MMA(0, 1, At, B1); PG8_BAR; PG8_SCHED;
            PG8_LDA(At, 1, 1); PG8_STAGE(PG8_SB(1, 0), b3, voffB); PG8_STAGE(PG8_SB(1, 1), b3 + hstepB, voffB); PG8_STAGE(PG8_SA(1, 0), a3, voffA);
            PG8_WAIT_V(8); PG8_WAIT_L(0); PG8_BAR; PG8_MMA(1, 0, At, B0); PG8_MMA(1, 1, At, B1); PG8_BAR; PG8_SCHED;
        }
        if constexpr (ALIGN_EPI) { if (wr == 0) PG8_BAR; }
        { int t2 = threadIdx.x; asm volatile("" : "+v"(t2));
          const int w2 = __builtin_amdgcn_readfirstlane(t2 >> 6), l2 = t2 & 63; E(acc, cur, w2 >> 2, w2 & 3, l2 & 15, l2 >> 4); } S.done(cur);
        if (!has_next) break;
#pragma unroll
        for (int a = 0; a < 2; ++a)
#pragma unroll
            for (int b = 0; b < 2; ++b)
#pragma unroll
                for (int m = 0; m < 4; ++m)
#pragma unroll
                    for (int n = 0; n < 2; ++n) acc[a][b][m][n] = (f32x4){0.f, 0.f, 0.f, 0.f};
        cur = nxt; cA = nA; cB = nB; ++ui;
        if constexpr (ALIGN_EPI) { if (wr == 1) PG8_BAR; }
    }
    PG8_WAIT_V(0);
    if constexpr (!ALIGN_EPI) { if (wr == 0) PG8_BAR; }
    PG8_BAR;
#undef PG8_SA
#undef PG8_SB
#undef PG8_STAGE
#undef PG8_LDA
#undef PG8_LDB
#undef PG8_MMA
#undef PG8_WAIT_V
#undef PG8_WAIT_L
#undef PG8_BAR
#undef PG8_SCHED
}
}

namespace attn_body {
using bf16=__hip_bfloat16;
using bf16x8=__attribute__((ext_vector_type(8)))short;
using s16x4=__attribute__((ext_vector_type(4)))short;
using f32x16=__attribute__((ext_vector_type(16)))float;
using u32x4=__attribute__((ext_vector_type(4)))unsigned;
constexpr int SEQ=8192,D=64,DM=1024;
constexpr int NW=8,QBLK=32,QB=QBLK*NW,KVBLK=64,NQB=SEQ/QB;
constexpr int ATTN_PITCH=DM, ATTN_UNIT_ROWS=QB;
__device__ __forceinline__ int crow(int r,int hi){return (r&3)+8*(r>>2)+4*hi;}
#define SBAR() __builtin_amdgcn_sched_barrier(0)
typedef __attribute__((address_space(3))) const float* lds_fptr;
__device__ __forceinline__ void cmask_bias(f32x16&p0,f32x16&p1,int jb,int qrel,int hi,lds_fptr tbl){
  const float NEG=-INFINITY; const int nb=qrel-64*jb-4*hi;
  #pragma unroll
  for(int r=0;r<16;++r){const int n0=nb-((r&3)+8*(r>>2)), n1=n0-32;
    const int i0=n0<0?0:(n0>127?127:n0), i1=n1<0?0:(n1>127?127:n1);
    const float b0=tbl[i0], b1=tbl[i1];
    p0[r]=(n0<0)?NEG:(p0[r]+b0); p1[r]=(n1<0)?NEG:(p1[r]+b1);
    if((r&3)==3) asm volatile("":::"memory");}
}

constexpr int NSLOT=3, SLOTB=8192, SLOTV=16384;
constexpr int LDS_K=0, LDS_V=NSLOT*SLOTB, LDS_WS=LDS_V+NSLOT*SLOTV, LDS_OST=LDS_WS+NW*64*4, LDS_BYTES=LDS_OST+NW*4096;
constexpr float C2=0.125f*1.4426950408889634f;
__device__ __forceinline__ void glds16(const void*gsrc,unsigned lds_dst){unsigned keep;
  asm volatile("s_mov_b32 %0, m0\n\ts_mov_b32 m0, %2\n\ts_nop 0\n\tglobal_load_lds_dwordx4 %1, off\n\ts_mov_b32 m0, %0":"=&s"(keep):"v"(gsrc),"s"(lds_dst):"memory");}
__device__ __forceinline__ float max3f(float a,float b,float c){float r;asm("v_max3_f32 %0, %1, %2, %3":"=v"(r):"v"(a),"v"(b),"v"(c));return r;}
__device__ __forceinline__ float max2f(float a,float b){float r;asm("v_max_f32_e32 %0, %1, %2":"=v"(r):"v"(a),"v"(b));return r;}
typedef float f32x2_t __attribute__((ext_vector_type(2))); typedef __bf16 bf16x2_t __attribute__((ext_vector_type(2)));
__device__ __forceinline__ unsigned cvtpk_s(float lo,float hi){f32x2_t v={lo,hi};bf16x2_t b=__builtin_convertvector(v,bf16x2_t);return __builtin_bit_cast(unsigned,b);}
#define WAIT_BAR(N) asm volatile("s_waitcnt vmcnt(" #N ") lgkmcnt(0)\n\ts_barrier":::"memory")

typedef __attribute__((address_space(3))) const char* lds_cptr;
typedef short v4i16_t __attribute__((ext_vector_type(4)));
#define LDSQ(p) (*(const __attribute__((address_space(3))) bf16x8*)(p))
__device__ __forceinline__ void qkt(f32x16&p0,f32x16&p1,const char*Kslot,const bf16x8*qr,int r32,int hi){
  const char*kb=Kslot+hi*1024+r32*16; const f32x16 z=f32x16{};
  #pragma unroll
  for(int d0=0;d0<4;++d0){
    const bf16x8 b0=*reinterpret_cast<const bf16x8*>(kb+d0*2048);
    const bf16x8 b1=*reinterpret_cast<const bf16x8*>(kb+d0*2048+512);
    const bf16x8 q=qr[d0];
    if(d0==0){p0=__builtin_amdgcn_mfma_f32_32x32x16_bf16(b0,q,z,0,0,0);p1=__builtin_amdgcn_mfma_f32_32x32x16_bf16(b1,q,z,0,0,0);}
    else{p0=__builtin_amdgcn_mfma_f32_32x32x16_bf16(b0,q,p0,0,0,0);p1=__builtin_amdgcn_mfma_f32_32x32x16_bf16(b1,q,p1,0,0,0);}}
}
__device__ __forceinline__ void kload8(bf16x8*kf,lds_cptr kp){
  kf[0]=LDSQ(kp);      kf[1]=LDSQ(kp+512);  kf[2]=LDSQ(kp+2048); kf[3]=LDSQ(kp+2560);
  kf[4]=LDSQ(kp+4096); kf[5]=LDSQ(kp+4608); kf[6]=LDSQ(kp+6144); kf[7]=LDSQ(kp+6656);
}
__device__ __forceinline__ void kload2(bf16x8*kf,lds_cptr kp,int j){ kf[2*j]=LDSQ(kp+j*2048); kf[2*j+1]=LDSQ(kp+j*2048+512); }
__device__ __forceinline__ s16x4 vtr(lds_cptr p){ return __builtin_bit_cast(s16x4,__builtin_amdgcn_ds_read_tr16_b64_v4i16((__attribute__((address_space(3))) v4i16_t*)p)); }
__device__ __forceinline__ float rowmax(const f32x16&p0,const f32x16&p1){
  float a=max3f(p0[0],p0[1],p1[0]),b=max3f(p0[2],p0[3],p1[1]);a=max3f(a,p1[2],p1[3]);
  #pragma unroll
  for(int r=4;r<16;r+=4){a=max3f(a,p0[r],p0[r+1]);b=max3f(b,p0[r+2],p0[r+3]);a=max3f(a,p1[r],p1[r+1]);b=max3f(b,p1[r+2],p1[r+3]);}
  const float m=max2f(a,b);
  auto rr=__builtin_amdgcn_permlane32_swap(__float_as_uint(m),__float_as_uint(m),false,false);
  return max2f(__uint_as_float(rr[0]),__uint_as_float(rr[1]));
}
__device__ __forceinline__ void pv(f32x16*o,int vb,bf16x8 pa0,bf16x8 pa1,bf16x8 pa2,bf16x8 pa3){
  #pragma unroll
  for(int d0=0;d0<4;++d0){s16x4 lo[4],hi[4];
    #pragma unroll
    for(int ks=0;ks<4;++ks){
      asm volatile("ds_read_b64_tr_b16 %0,%1 offset:%c2":"=&v"(lo[ks]):"v"(vb),"i"(d0*4096+ks*1024):"memory");
      asm volatile("ds_read_b64_tr_b16 %0,%1 offset:%c2":"=&v"(hi[ks]):"v"(vb),"i"(d0*4096+ks*1024+512):"memory");}
    asm volatile("s_waitcnt lgkmcnt(0)":::"memory");SBAR();
    #define PK(k) (bf16x8){lo[k][0],lo[k][1],lo[k][2],lo[k][3],hi[k][0],hi[k][1],hi[k][2],hi[k][3]}
    o[d0]=__builtin_amdgcn_mfma_f32_32x32x16_bf16(pa0,PK(0),o[d0],0,0,0);
    o[d0]=__builtin_amdgcn_mfma_f32_32x32x16_bf16(pa1,PK(1),o[d0],0,0,0);
    o[d0]=__builtin_amdgcn_mfma_f32_32x32x16_bf16(pa2,PK(2),o[d0],0,0,0);
    o[d0]=__builtin_amdgcn_mfma_f32_32x32x16_bf16(pa3,PK(3),o[d0],0,0,0);
    #undef PK
  }
}

#ifndef ATTN_STORE16
#define ATTN_STORE16(p,v) (*(u32x4*)(p)=(v))
#endif
template<int THRL> __device__ __forceinline__ void attn_unit(int b,int qcol,int vcol,int qb,const bf16*Q,const bf16*__restrict__ K,const bf16*__restrict__ V,bf16*O,char*shm,lds_fptr tbl){
  int tid_=threadIdx.x; asm volatile("":"+v"(tid_));
  const int tid=tid_,lane=tid&63,r32=lane&31,hi=lane>>5; const int wid=__builtin_amdgcn_readfirstlane(tid>>6);
  const long rowbase=(long)b*SEQ; const int q0=qb*QB;
  const bf16*Qw=Q+(rowbase+q0+wid*QBLK)*DM+qcol;
  const bf16*Kh=K+rowbase*DM+qcol,*Vh=V+rowbase*DM+vcol;
  const unsigned lds0=(unsigned)(uintptr_t)shm;
  float*wsf=(float*)(shm+LDS_WS)+wid*64;
  const bf16*ksrc=Kh+(long)lane*DM+wid*8;
  const bf16*vsrc=Vh+(long)(16*(wid&3)+(lane>>2))*DM+(wid>>2)*32+(lane&3)*8;
  const unsigned kdst=lds0+LDS_K+wid*1024, vdst=lds0+LDS_V+wid*1024, qdst=lds0+LDS_OST+wid*4096;
  #define RFL(x) ((unsigned)__builtin_amdgcn_readfirstlane((int)(x)))
  #define DMA_K(t,slot) glds16(ksrc+(long)(t)*KVBLK*DM,RFL(kdst+(slot)))
  #define DMA_V(t,slot) do{ glds16(vsrc+(long)(t)*KVBLK*DM,RFL(vdst+2*(slot))); glds16(vsrc+(long)(t)*KVBLK*DM+64,RFL(vdst+2*(slot)+8192)); }while(0)
  const int vb0=(int)(lds0+LDS_V)+((lane>>4)&1)*32+(lane&3)*8+(4*hi+((lane&15)>>2))*64;
  const char*Kbase=shm+LDS_K; bf16x8 kf[8];
  const lds_cptr shm3=(lds_cptr)shm; const lds_cptr kp0=shm3+LDS_K+hi*1024+r32*16; const lds_cptr vp0=shm3+LDS_V+((lane>>4)&1)*32+(lane&3)*8+(4*hi+((lane&15)>>2))*64;
  const lds_cptr qp0=shm3+LDS_OST+wid*4096+lane*16;
  const int NT=(q0+QB)/KVBLK;
  #pragma unroll
  for(int d0=0;d0<4;++d0)glds16(Qw+(long)r32*DM+d0*16+hi*8,RFL(qdst+d0*1024));
  DMA_K(0,0);DMA_V(0,0);DMA_K(1,SLOTB);
  float mhat=0.f,l_reg=0.f;f32x16 o[4];o[0]=f32x16{};o[1]=f32x16{};o[2]=f32x16{};o[3]=f32x16{};
  const int qrel=wid*QBLK+r32;
  #define CMASK(P0,P1,t) do{int jb_=(t)-(NT-4); if(jb_>=-2)cmask_bias(P0,P1,jb_,qrel,hi,tbl);}while(0)
  #define EX(v) __builtin_amdgcn_exp2f(v)
  bool resc=false;
  #define RESC() do{ if(resc){ asm volatile("s_waitcnt lgkmcnt(0)":::"memory"); \
      _Pragma("unroll") for(int d_=0;d_<4;++d_) _Pragma("unroll") for(int r=0;r<16;++r)o[d_][r]*=wsf[crow(r,hi)]; } }while(0)
  f32x16 pA0,pA1,pB0,pB1;
  int sl_prev=0,sl_cur=0,sl_next=SLOTB;
  #define ROT() do{sl_prev=sl_cur;sl_cur=sl_next;sl_next=(sl_next==(NSLOT-1)*SLOTB)?0:sl_next+SLOTB;}while(0)
  DMA_K(2,2*SLOTB);
  WAIT_BAR(4);
  bf16x8 qr[4];
  #pragma unroll
  for(int d0=0;d0<4;++d0)qr[d0]=LDSQ(qp0+d0*1024);
  qkt(pA0,pA1,Kbase,qr,r32,hi);CMASK(pA0,pA1,0);
  mhat=rowmax(pA0,pA1);
  _Pragma("unroll") for(int r=0;r<16;++r){pA0[r]=EX(pA0[r]-mhat);pA1[r]=EX(pA1[r]-mhat);}
  WAIT_BAR(0);
  DMA_K(3,0);DMA_V(1,SLOTB);
  ROT();
  kload8(kf,kp0+sl_cur);
  WAIT_BAR(3);
  s16x4 vlo[8],vhi[8]; u32x4 pw0,pw1,pw2,pw3;
  #define PKW(P,B) cvtpk_s(P[B],P[B+1])
  #define PAF(k) __builtin_bit_cast(bf16x8,pw##k)
  #define VFR(i) (bf16x8){vlo[i][0],vlo[i][1],vlo[i][2],vlo[i][3],vhi[i][0],vhi[i][1],vhi[i][2],vhi[i][3]}
  #define PIN(x) asm volatile("":"+v"(x))
  #define MX3(a,b,c) __builtin_fmaxf(__builtin_fmaxf((a),(b)),(c))
  #define MF(a,b,c) __builtin_amdgcn_mfma_f32_32x32x16_bf16(a,b,c,0,0,0)
  #define GAPA(MFS,A0,A1,A2,A3,W0,W1,PW) do{ MFS; sacc+=A0; sacc+=A1; sacc+=A2; sacc+=A3; PIN(sacc); W0; W1; PIN(PW); SBAR(); }while(0)
  #define GAPB(MFS,X,B) do{ MFS; X[B]=EX(X[B]-mhat); X[B+1]=EX(X[B+1]-mhat); PIN(X); SBAR(); }while(0)
  #define VRD(i) do{ vlo[i]=vtr(vp_+(((i)>>2)*4096+((i)&3)*1024)); vhi[i]=vtr(vp_+(((i)>>2)*4096+((i)&3)*1024+512)); }while(0)
  #define VRD2(i) do{ vlo[i]=vtr(vp_+((((i)>>2)+2)*4096+((i)&3)*1024)); vhi[i]=vtr(vp_+((((i)>>2)+2)*4096+((i)&3)*1024+512)); }while(0)
  #define KRD(G,j) do{ if(G){ kload2(kf,kp0+sl_next,j); } }while(0)
  #define STEP(C0,C1,P0,P1,t,GK,GV,GL) do{ SBAR(); \
    if(GK){DMA_K((t)+3,sl_cur);} if(GV){DMA_V((t)+1,sl_next);} SBAR(); \
    const lds_cptr vp_=vp0+2*sl_prev; const f32x16 z16_=f32x16{}; \
    VRD(0); SBAR(); float sacc=(P0[0]+P0[1]); \
    GAPA(C0=MF(kf[0],qr[0],z16_), P0[2],P0[3],P0[4],P0[5],     pw0[0]=PKW(P0,0), pw0[1]=PKW(P0,2), pw0); \
    VRD(4); SBAR(); GAPA(C1=MF(kf[1],qr[0],z16_), P0[6],P0[7],P0[8],P0[9],     pw0[2]=PKW(P0,4), pw0[3]=PKW(P0,6), pw0); \
    VRD(1); SBAR(); GAPA(C0=MF(kf[2],qr[1],C0),   P0[10],P0[11],P0[12],P0[13], pw1[0]=PKW(P0,8), pw1[1]=PKW(P0,10), pw1); \
    VRD(5); SBAR(); GAPA(C1=MF(kf[3],qr[1],C1),   P0[14],P0[15],P1[0],P1[1],   pw1[2]=PKW(P0,12),pw1[3]=PKW(P0,14), pw1); \
    VRD(2); SBAR(); GAPA(C0=MF(kf[4],qr[2],C0),   P1[2],P1[3],P1[4],P1[5],     pw2[0]=PKW(P1,0), pw2[1]=PKW(P1,2), pw2); \
    VRD(6); SBAR(); GAPA(C1=MF(kf[5],qr[2],C1),   P1[6],P1[7],P1[8],P1[9],     pw2[2]=PKW(P1,4), pw2[3]=PKW(P1,6), pw2); \
    VRD(3); SBAR(); GAPA(C0=MF(kf[6],qr[3],C0),   P1[10],P1[11],P1[12],P1[13], pw3[0]=PKW(P1,8), pw3[1]=PKW(P1,10), pw3); \
    VRD(7); SBAR(); GAPA(C1=MF(kf[7],qr[3],C1),   P1[14],P1[15],0.f,0.f,       pw3[2]=PKW(P1,12),pw3[3]=PKW(P1,14), pw3); \
    l_reg+=sacc; \
    CMASK(C0,C1,t); \
    { float a=MX3(C0[0],C0[1],C1[0]),bq=MX3(C0[2],C0[3],C1[1]); a=MX3(a,C1[2],C1[3]); \
      _Pragma("unroll") for(int r=4;r<16;r+=4){a=MX3(a,C0[r],C0[r+1]);bq=MX3(bq,C0[r+2],C0[r+3]);a=MX3(a,C1[r],C1[r+1]);bq=MX3(bq,C1[r+2],C1[r+3]);} \
      float rm=__builtin_fmaxf(a,bq); { auto rr=__builtin_amdgcn_permlane32_swap(__float_as_uint(rm),__float_as_uint(rm),false,false); rm=__builtin_fmaxf(__uint_as_float(rr[0]),__uint_as_float(rr[1])); } \
      resc=false; const float grow=rm-mhat; \
      if(__builtin_expect(__any(grow>(float)THRL),0)){ const float dl=__builtin_fmaxf(grow,0.f); mhat+=dl; \
        const float f=__builtin_amdgcn_exp2f(-dl); l_reg*=f; if(hi==0)wsf[r32]=f; resc=true; } } \
    SBAR(); \
    GAPB(o[0]=MF(PAF(0),VFR(0),o[0]), C0,0); \
    VRD2(0); GAPB(o[1]=MF(PAF(0),VFR(4),o[1]), C0,2); \
    VRD2(4); GAPB(o[0]=MF(PAF(1),VFR(1),o[0]), C0,4); \
    VRD2(1); GAPB(o[1]=MF(PAF(1),VFR(5),o[1]), C0,6); \
    VRD2(5); GAPB(o[0]=MF(PAF(2),VFR(2),o[0]), C0,8); \
    VRD2(2); GAPB(o[1]=MF(PAF(2),VFR(6),o[1]), C0,10); \
    VRD2(6); GAPB(o[0]=MF(PAF(3),VFR(3),o[0]), C0,12); \
    VRD2(3); GAPB(o[1]=MF(PAF(3),VFR(7),o[1]), C0,14); \
    VRD2(7); GAPB(o[2]=MF(PAF(0),VFR(0),o[2]), C1,0); \
    KRD(GL,0); GAPB(o[3]=MF(PAF(0),VFR(4),o[3]), C1,2); \
    KRD(GL,1); GAPB(o[2]=MF(PAF(1),VFR(1),o[2]), C1,4); \
    KRD(GL,2); GAPB(o[3]=MF(PAF(1),VFR(5),o[3]), C1,6); \
    KRD(GL,3); GAPB(o[2]=MF(PAF(2),VFR(2),o[2]), C1,8); \
    GAPB(o[3]=MF(PAF(2),VFR(6),o[3]), C1,10); \
    GAPB(o[2]=MF(PAF(3),VFR(3),o[2]), C1,12); \
    GAPB(o[3]=MF(PAF(3),VFR(7),o[3]), C1,14); \
    }while(0)
  int t=1;
  #undef CMASK
  #define CMASK(P0,P1,t) do{}while(0)
  for(;t+7<NT;t+=2){
    STEP(pB0,pB1,pA0,pA1,t,true,true,true);     WAIT_BAR(3); RESC(); ROT();
    STEP(pA0,pA1,pB0,pB1,t+1,true,true,true);   WAIT_BAR(3); RESC(); ROT();
  }
  #undef CMASK
  #define CMASK(P0,P1,t) do{int jb_=(t)-(NT-4); if(jb_>=-2)cmask_bias(P0,P1,jb_,qrel,hi,tbl);}while(0)
  #define ENDW(tt) do{ if((tt)+3<NT){WAIT_BAR(3);} else if((tt)+2<NT){WAIT_BAR(2);} else {WAIT_BAR(0);} }while(0)
  for(;t+1<NT;t+=2){
    STEP(pB0,pB1,pA0,pA1,t,(t+3<NT),(t+1<NT),(t+1<NT));       ENDW(t);   RESC(); ROT();
    STEP(pA0,pA1,pB0,pB1,t+1,(t+4<NT),(t+2<NT),(t+2<NT));     ENDW(t+1); RESC(); ROT();
  }
  int vslot_=sl_cur;
  if(wid>=6){ STEP(pB0,pB1,pA0,pA1,NT-1,false,false,false); RESC(); }
  else { pB0=pA0; pB1=pA1; vslot_=sl_prev; }
  { float sacc=pB0[0]+pB0[1]; _Pragma("unroll") for(int r=2;r<16;++r)sacc+=pB0[r]; _Pragma("unroll") for(int r=0;r<16;++r)sacc+=pB1[r]; l_reg+=sacc;
    pw0=(u32x4){PKW(pB0,0),PKW(pB0,2),PKW(pB0,4),PKW(pB0,6)};pw1=(u32x4){PKW(pB0,8),PKW(pB0,10),PKW(pB0,12),PKW(pB0,14)};pw2=(u32x4){PKW(pB1,0),PKW(pB1,2),PKW(pB1,4),PKW(pB1,6)};pw3=(u32x4){PKW(pB1,8),PKW(pB1,10),PKW(pB1,12),PKW(pB1,14)};
    SBAR(); pv(o,vb0+2*vslot_,PAF(0),PAF(1),PAF(2),PAF(3)); }
  #undef PKW
  #undef PAF
  #undef VFR
  #undef PIN
  #undef MX3
  #undef MF
  #undef GAPA
  #undef GAPB
  #undef EX
  #undef VRD
  #undef VRD2
  #undef KRD
  #undef STEP
  #undef ENDW
  {auto rr=__builtin_amdgcn_permlane32_swap(__float_as_uint(l_reg),__float_as_uint(l_reg),false,false);l_reg=__uint_as_float(rr[0])+__uint_as_float(rr[1]);}
  if(hi==0)wsf[32+r32]=l_reg;asm volatile("s_waitcnt lgkmcnt(0)":::"memory");
  float rli[16];
  #pragma unroll
  for(int r=0;r<16;++r)rli[r]=__builtin_amdgcn_rcpf(wsf[32+crow(r,hi)]);
  bf16*Ow=O+(rowbase+q0+wid*QBLK)*DM+vcol;
  { bf16*stg=(bf16*)(shm+LDS_OST)+wid*2048;
    #pragma unroll
    for(int h=0;h<2;++h){
      #pragma unroll
      for(int r=0;r<16;++r){const int orow=crow(r,hi);
        #pragma unroll
        for(int d0=0;d0<2;++d0)stg[orow*64+d0*32+r32]=__float2bfloat16(o[2*h+d0][r]*rli[r]);}
      asm volatile("s_waitcnt lgkmcnt(0)":::"memory");
      #pragma unroll
      for(int i=0;i<4;++i){const int row=i*8+(lane>>3),ch=lane&7; const u32x4 v=*(const u32x4*)(stg+row*64+ch*8); ATTN_STORE16(Ow+(long)row*DM+h*64+ch*8,v);}
      asm volatile("s_waitcnt lgkmcnt(0)":::"memory");
    } }
  asm volatile("s_waitcnt lgkmcnt(0)\n\ts_barrier":::"memory");
  #undef DMA_K
  #undef DMA_V
  #undef RFL
  #undef CMASK
  #undef RESC
  #undef ROT
}
constexpr int ATTN_LDS_BYTES=LDS_BYTES;
struct AttnTensors { const bf16* Q; const bf16* K; const bf16* V; bf16* O0; bf16* O1; };
template<int THRL=8> __device__ __forceinline__ void attn_phase(char*lds,const AttnTensors&T,int x,int a,int A8,lds_fptr tbl_all){
  if(A8==32){
    const int g=a>>4, a4=a&15;
    for(int ss=0;ss<2;++ss){
      const int st=4*x+2*ss+g, b=st>>4, head=(st>>1)&7, c=st&1;
      attn_unit<THRL>(b,head*128+c*64,head*128,31-a4,T.Q,T.K,T.V,c?T.O1:T.O0,lds,tbl_all+head*128);
      attn_unit<THRL>(b,head*128+c*64,head*128,a4,T.Q,T.K,T.V,c?T.O1:T.O0,lds,tbl_all+head*128);
    }
    return;
  }
  for(int r=0; r*A8<128; ++r){
    const int j=r*A8+((r&1)?(A8-1-a):a); if(j>=128)continue;
    const int qb=31-(j>>2), st=4*x+(j&3), b=st>>4, head=(st>>1)&7, c=st&1;
    attn_unit<THRL>(b,head*128+c*64,head*128,qb,T.Q,T.K,T.V,c?T.O1:T.O0,lds,tbl_all+head*128);
  }
}
#undef SBAR
#undef WAIT_BAR
}

#define GAS __attribute__((address_space(1)))
#define LAS __attribute__((address_space(3)))
typedef unsigned short bf16;
typedef unsigned v4u __attribute__((ext_vector_type(4)));
typedef float f32x4 __attribute__((ext_vector_type(4)));
typedef short bf16x8 __attribute__((ext_vector_type(8)));
typedef GAS unsigned gu32;
typedef GAS unsigned long long gu64;
#define RLX_AGENT __ATOMIC_RELAXED, __HIP_MEMORY_SCOPE_AGENT
#define LDS_WAIT() asm volatile("s_waitcnt lgkmcnt(0)" ::: "memory")
#define VM_WAIT() asm volatile("s_waitcnt vmcnt(0)" ::: "memory")
__device__ __forceinline__ unsigned long long rt() { return __builtin_amdgcn_s_memrealtime(); }
__device__ __forceinline__ unsigned f2bf(float f) { unsigned u = __builtin_bit_cast(unsigned, f); return (u + 0x7fffu + ((u >> 16) & 1u)) >> 16; }
__device__ __forceinline__ unsigned pk2(float lo, float hi) { return f2bf(lo) | (f2bf(hi) << 16); }

#define XB_TMO      128
#define XB_XCNT(j)  (256  + 64 * (j))
#define XB_XSUB(j)  (1280 + 64 * (j))
#define XB_XGEN(j)  (2304 + 64 * (j))
#define XB_TOP      3328
#define XB_TOPGEN   3392
#define XCD_BAR_WORDS 3456
#define XB_SPIN_CAP (1u << 18)

__device__ __forceinline__ unsigned xb_ld(unsigned* p)              { return __hip_atomic_load(p, __ATOMIC_RELAXED, __HIP_MEMORY_SCOPE_AGENT); }
__device__ __forceinline__ unsigned xb_add(unsigned* p, unsigned v) { return __hip_atomic_fetch_add(p, v, __ATOMIC_RELAXED, __HIP_MEMORY_SCOPE_AGENT); }
__device__ __forceinline__ unsigned xb_xcc_id() { return (unsigned)__builtin_amdgcn_s_getreg((3 << 11) | 20) & 0xFu; }
#define XB_SPIN(cond, bar) do { unsigned _sp = 0; while (cond) { __builtin_amdgcn_s_sleep(1); \
    if ((++_sp & 255u) == 0u) { if (xb_ld(&(bar)[XB_TMO])) break; if (_sp > XB_SPIN_CAP) { atomicAdd(&(bar)[XB_TMO], 1u); break; } } } } while (0)

struct XcdBarrier {
    unsigned* bar; unsigned x;
    volatile LAS unsigned* st;
};

__device__ __forceinline__ XcdBarrier xcd_barrier_post(unsigned* bar, volatile LAS unsigned* st) {
    XcdBarrier b; b.bar = bar; b.x = xb_xcc_id(); b.st = st;
    if (threadIdx.x == 0) (void)xb_add(&bar[XB_XCNT(b.x)], 1u);
    return b;
}
__device__ __forceinline__ void xcd_barrier_complete(unsigned* bar, unsigned x, unsigned& nloc, unsigned& nx) {
    const unsigned G = gridDim.x * gridDim.y * gridDim.z;
    unsigned sum, cnt, mine, sp = 0u;
    for (;;) {
        sum = 0u; cnt = 0u; mine = 0u;
#pragma unroll
        for (unsigned j = 0; j < 16; ++j) { const unsigned c = xb_ld(&bar[XB_XCNT(j)]); sum += c; cnt += (c > 0u) ? 1u : 0u; mine = (j == x) ? c : mine; }
        if (sum == G) break;
        __builtin_amdgcn_s_sleep(1);
        if ((++sp & 255u) == 0u) { if (xb_ld(&bar[XB_TMO])) break; if (sp > XB_SPIN_CAP) { atomicAdd(&bar[XB_TMO], 1u); break; } }
    }
    nloc = mine > 0u ? mine : 1u; nx = cnt > 0u ? cnt : 1u;
}

__device__ __forceinline__ void xcd_barrier(const XcdBarrier& b) {
    asm volatile("s_waitcnt vmcnt(0)" ::: "memory");
    __syncthreads();
    if (threadIdx.x == 0) {
        unsigned* bar = b.bar;
        __builtin_amdgcn_s_waitcnt(0);
        unsigned nloc = b.st[0], nx = b.st[1];
        if (nloc == 0u) { xcd_barrier_complete(bar, b.x, nloc, nx); b.st[0] = nloc; b.st[1] = nx; }
        const unsigned old = xb_add(&bar[XB_XSUB(b.x)], 1u);
        const unsigned gen = old / nloc;
        if (old + 1u == (gen + 1u) * nloc) {
            __builtin_amdgcn_fence(__ATOMIC_RELEASE, "agent");
            asm volatile("s_waitcnt vmcnt(0)" ::: "memory");
            const unsigned og = xb_add(&bar[XB_TOP], 1u);
            const unsigned tg = og / nx;
            if (og + 1u == (tg + 1u) * nx) xb_add(&bar[XB_TOPGEN], 1u);
            else XB_SPIN(xb_ld(&bar[XB_TOPGEN]) == tg, bar);
            __builtin_amdgcn_fence(__ATOMIC_ACQUIRE, "agent");
            xb_add(&bar[XB_XGEN(b.x)], 1u);
            asm volatile("s_waitcnt vmcnt(0)" ::: "memory");
        } else {
            XB_SPIN(xb_ld(&bar[XB_XGEN(b.x)]) == gen, bar);
            __builtin_amdgcn_fence(__ATOMIC_ACQUIRE, "agent");
            asm volatile("s_waitcnt vmcnt(0)" ::: "memory");
        }
    }
    __syncthreads();
}

constexpr int NWAVES = 8;
constexpr int NPHASE = 22;
constexpr int ATT_CU_PER_XCD_L0 = 20;
#ifndef MK_N_LAUNCHES
#define MK_N_LAUNCHES 1
#endif
constexpr int N_LAUNCHES = MK_N_LAUNCHES;
static_assert(N_LAUNCHES == 1 || N_LAUNCHES == NPHASE, "MK_N_LAUNCHES is 1 or NPHASE");

constexpr size_t MiB = 1u << 20;
constexpr size_t WS_CTL = 0, CTL_ZERO_BYTES = 1 * MiB;
constexpr size_t WS_TAB = 1 * MiB;
constexpr size_t WS_TOKINFO = 2 * MiB;
constexpr size_t WS_ROWMAP = 2 * MiB + 512 * 1024, WS_ROWW = 2 * MiB + 768 * 1024, WS_BBASE = 3 * MiB;
constexpr size_t WS_WIN = 4 * MiB, WS_WCAT = 68 * MiB  , WS_WBP = 84 * MiB, WS_WOUT = 92 * MiB, WS_POOLB = 108 * MiB;
constexpr size_t WS_WGU_D = 110 * MiB, WS_WD_D = 154 * MiB, WS_WGU_E = 176 * MiB, WS_WD_E = 624 * MiB, WS_AB = 848 * MiB;
constexpr size_t WS_H = WS_AB, WS_XB = WS_AB + 128 * MiB, WS_O0 = WS_AB + 192 * MiB, WS_O1 = WS_AB + 224 * MiB, WS_AO = WS_AB + 256 * MiB, WS_ZB = WS_AB + 288 * MiB;
constexpr size_t WS_MG = WS_AB + 320 * MiB, WS_MERGED = WS_AB + 448 * MiB, WS_ACT_D = WS_AB + 192 * MiB, WS_ACT_E = WS_AB + 128 * MiB;
constexpr size_t WIN_F8_OFF = 16 * MiB;
constexpr size_t WS_X8IN = WS_O0;
constexpr size_t WS_QKV = WS_AB + 604 * MiB, WS_Y = WS_H  , WS_STATS = WS_TAB + 64 * 1024  , WS_XS = WS_QKV, WS_Y2 = WS_AB + 700 * MiB  , WS_END = WS_AB + 860 * MiB;
constexpr int MAXROWS = 34816;
static_assert(WS_WIN + 2 * (size_t)INW * DM_ * 2 <= WS_WCAT && WS_WCAT + 2 * (size_t)DM_ * DM_ * 2 <= WS_WBP && WS_WBP + 2 * (size_t)DM_ * PW * 2 <= WS_WOUT && WS_WOUT + 2 * (size_t)DM_ * DM_ * 2 <= WS_POOLB && WS_WGU_D + (size_t)2 * FFD * DM_ * 2 <= WS_WD_D && WS_WD_D + (size_t)FFD * DM_ * 2 <= WS_WGU_E, "ws map 1");
static_assert(WS_WGU_E + (size_t)NEXP * 2 * FFE * DM_ * 2 <= WS_WD_E && WS_WD_E + (size_t)NEXP * FFE * DM_ * 2 <= WS_AB, "ws map 2");
static_assert(WS_ACT_E + (size_t)MAXROWS * FFE * 2 <= WS_QKV && WS_XS + (size_t)MAXROWS * DM_ * 2 <= WS_END && WS_Y2 + (size_t)2 * TOK * DM_ * 2 <= WS_END && WS_XS + (size_t)MAXROWS * DM_ <= WS_Y2 && WS_ACT_D + (size_t)TOK * FFD * 2 <= WS_QKV, "ws map 3");
constexpr int CW_BAR = 4096;
constexpr int CW_PANEL = 32768;
constexpr int CW_CNT = 16384;

constexpr int RING_OFF = 0, RING_BYTES = 131072;
constexpr int ATT_TBL_OFF = 110592;
constexpr int LDSCTL_OFF = RING_BYTES, MISC_OFF = LDSCTL_OFF + 320;
constexpr int LDS_BYTES = 147456;
static_assert(attn_body::ATTN_LDS_BYTES <= ATT_TBL_OFF && ATT_TBL_OFF + 4096 <= RING_BYTES, "attention LDS");

typedef unsigned u32x4_t __attribute__((ext_vector_type(4)));
typedef unsigned u32x2_t __attribute__((ext_vector_type(2)));
template <int CTRL> __device__ __forceinline__ float dppf(float v) { return __int_as_float(__builtin_amdgcn_update_dpp(0, __float_as_int(v), CTRL, 0xF, 0xF, false)); }
__device__ __forceinline__ float row16_sum(float v) {
    v += dppf<0xB1>(v); v += dppf<0x4E>(v); v += dppf<0x141>(v); v += dppf<0x140>(v); return v;
}
__device__ __forceinline__ float wave_sum(float v) {
    v = row16_sum(v);
    const float s0 = __int_as_float(__builtin_amdgcn_readlane(__float_as_int(v), 0)), s1 = __int_as_float(__builtin_amdgcn_readlane(__float_as_int(v), 16));
    const float s2 = __int_as_float(__builtin_amdgcn_readlane(__float_as_int(v), 32)), s3 = __int_as_float(__builtin_amdgcn_readlane(__float_as_int(v), 48));
    return (s0 + s1) + (s2 + s3);
}
__device__ __forceinline__ float ld_f32_agent(const float* p) { return __uint_as_float(__hip_atomic_load((const unsigned*)p, __ATOMIC_RELAXED, __HIP_MEMORY_SCOPE_AGENT)); }
__device__ __forceinline__ unsigned ld_u32_agent(const unsigned* p) { return __hip_atomic_load(p, __ATOMIC_RELAXED, __HIP_MEMORY_SCOPE_AGENT); }


__device__ __forceinline__ void p0_transpose_item(const float* W, int ldw, int K, int N, bf16* WT, int mode, LAS float* scr, int item, int lane) {
    const int nblk = N / 32, kb = item / nblk, nb = item % nblk, k0 = 64 * kb, n0 = 32 * nb;
    const int d0 = (mode == 0) ? n0 : (((n0 >> 7) << 8) + (n0 & 127) + (mode == 2 ? 128 : 0));
    float tv[32];
#pragma unroll
    for (int i = 0; i < 32; ++i) tv[i] = W[(size_t)(k0 + 2 * i + (lane >> 5)) * ldw + n0 + (lane & 31)];
#pragma unroll
    for (int i = 0; i < 32; ++i) scr[(2 * i + (lane >> 5)) * 33 + (lane & 31)] = tv[i];
    LDS_WAIT(); asm volatile("" ::: "memory");
    const int c = lane & 7;
#pragma unroll
    for (int j = 0; j < 4; ++j) { const int n = (lane >> 3) + 8 * j; const LAS float* s = scr + (8 * c) * 33 + n;
        v4u o; o.x = pk2(s[0 * 33], s[1 * 33]); o.y = pk2(s[2 * 33], s[3 * 33]); o.z = pk2(s[4 * 33], s[5 * 33]); o.w = pk2(s[6 * 33], s[7 * 33]);
        *(GAS v4u*)(WT + (size_t)(d0 + n) * K + k0 + 8 * c) = o; }
    LDS_WAIT(); asm volatile("" ::: "memory");
}

__device__ __forceinline__ void p0_item_load(const float* W, int ldw, int N, int item, int lane, float (&tv)[32]) {
    const int nblk = N / 32, kb = item / nblk, nb = item % nblk, k0 = 64 * kb, n0 = 32 * nb;
#pragma unroll
    for (int i = 0; i < 32; ++i) tv[i] = __builtin_nontemporal_load(W + (size_t)(k0 + 2 * i + (lane >> 5)) * ldw + n0 + (lane & 31));
}
__device__ __forceinline__ void p0_item8_finish(const float (&tv)[32], int K, int N, unsigned char* WT, int mode, float scale, LAS float* scr, int item, int lane) {
    const int nblk = N / 32, kb = item / nblk, nb = item % nblk, k0 = 64 * kb, n0 = 32 * nb;
    const int d0 = (mode == 0) ? n0 : (((n0 >> 7) << 8) + (n0 & 127) + (mode == 2 ? 128 : 0));
#pragma unroll
    for (int i = 0; i < 32; ++i) scr[(2 * i + (lane >> 5)) * 33 + (lane & 31)] = tv[i];
    LDS_WAIT(); asm volatile("" ::: "memory");
    const int c = lane & 3;
#pragma unroll
    for (int j = 0; j < 2; ++j) { const int n = (lane >> 2) + 16 * j; const LAS float* p = scr + (16 * c) * 33 + n;
        v4u o;
        o.x = pg8::pk4_fp8(p[0 * 33] * scale, p[1 * 33] * scale, p[2 * 33] * scale, p[3 * 33] * scale);     o.y = pg8::pk4_fp8(p[4 * 33] * scale, p[5 * 33] * scale, p[6 * 33] * scale, p[7 * 33] * scale);
        o.z = pg8::pk4_fp8(p[8 * 33] * scale, p[9 * 33] * scale, p[10 * 33] * scale, p[11 * 33] * scale);   o.w = pg8::pk4_fp8(p[12 * 33] * scale, p[13 * 33] * scale, p[14 * 33] * scale, p[15 * 33] * scale);
        *(GAS v4u*)(WT + (size_t)(d0 + n) * K + k0 + 16 * c) = o; }
    LDS_WAIT(); asm volatile("" ::: "memory");
}
__device__ __forceinline__ void p0_transpose_item8(const float* W, int ldw, int K, int N, unsigned char* WT, int mode, float scale, LAS float* scr, int item, int lane) {
    float tv[32]; p0_item_load(W, ldw, N, item, lane, tv); p0_item8_finish(tv, K, N, WT, mode, scale, scr, item, lane);
}
constexpr float W8_SCALE_UP = 256.0f, W8_SCALE_DOWN = 1024.0f, X8_SCALE = 4.0f;

constexpr int CONV_NB_PRE = 4160, CONV_BPM = (DM_ / 128) * (FFE / 128), CONV_TOTB = CONV_NB_PRE + 24 * CONV_BPM;
__host__ __device__ __forceinline__ int win_src_col(int n, int comp) {
    if (n < 1024) return (n >> 9) * 1024 + (((n & 511) >> 6) << 7) + comp * 64 + (n & 63);
    return (comp ? 4096 : 2048) + (n - 1024);
}
struct ConvBlk { const float* src; unsigned char* dst; int ldw, pitch, f8; float sc; int gath; };
#define CONV_PTR_PARAMS unsigned char* wsb, const float* in1, const float* in6, const float* in7, const float* in8, const float* in12, const float* in13, const float* in14, const float* in16, const float* in17, const float* in18
#define CONV_PTR_ARGS P_ws, P_in1, P_in6, P_in7, P_in8, P_in12, P_in13, P_in14, P_in16, P_in17, P_in18
__device__ __forceinline__ ConvBlk conv_decode(int b, CONV_PTR_PARAMS) {
    ConvBlk c;
    if (b >= CONV_NB_PRE) {
        const int bb = b - CONV_NB_PRE, j = bb / CONV_BPM, r = bb - j * CONV_BPM, kind = j >> 3, e = j & 7; const int K = kind == 2 ? FFE : DM_, N = kind == 2 ? DM_ : FFE, nbn = N / 128, kb = r / nbn, nb = r - kb * nbn;
        const float* sk = in16; if (kind == 1) sk = in17; if (kind == 2) sk = in18;
        c.src = sk + (size_t)e * DM_ * FFE + (size_t)(128 * kb) * N + 128 * nb; c.ldw = N; c.pitch = K; c.f8 = 1; c.sc = kind == 2 ? W8_SCALE_DOWN : W8_SCALE_UP;
        c.dst = (kind == 2 ? wsb + WS_WD_E + (size_t)e * DM_ * FFE + (size_t)(128 * nb) * K : wsb + WS_WGU_E + (size_t)e * 2 * FFE * DM_ + (size_t)(256 * nb + 128 * kind) * K) + 128 * kb; c.gath = 0;
        return c; }
    int r = b; const float* src = nullptr; unsigned char* dst = nullptr; int ldw = 0, K = 0, N = 0, f8 = 0, mode = 0, pitch = 0; bool hit = false;
#define CONV_JOB(CNT, SRC, LDW, KK, NN, DST, F8, MODE) if (!hit) { if (r < (CNT)) { src = (SRC); ldw = (LDW); K = (KK); N = (NN); dst = (DST); f8 = (F8); mode = (MODE) & 3; pitch = ((MODE) >> 2) ? ((MODE) >> 2) : ((F8) ? (KK) : 2 * (KK)); hit = true; } else r -= (CNT); }
    CONV_JOB(128, in6, DM_, AW, DM_, wsb + WS_WCAT, 0, (4096 << 2))
    CONV_JOB(128, in7, DM_, PW, DM_, wsb + WS_WBP, 0, 0)
    CONV_JOB(256, in8, DM_, DM_, DM_, wsb + WS_WOUT, 0, 0)
    CONV_JOB(704, in12, FFD, DM_, FFD, wsb + WS_WGU_D, 1, 1)
    CONV_JOB(704, in13, FFD, DM_, FFD, wsb + WS_WGU_D, 1, 2)
    CONV_JOB(704, in14, DM_, FFD, DM_, wsb + WS_WD_D, 1, 0)
    int win = 0;
    if (!hit) { if (r < 384) { win = 1; } else r -= 384; }
    CONV_JOB(win == 1 ? 1 << 30 : 0, in1 + (size_t)DM_ * INW, INW, DM_, 3072, wsb + WS_WIN + (size_t)INW * DM_ * 2, 0, 0)
    if (!hit) { if (r < 640) { win = 2; } else r -= 640; }
    CONV_JOB(win == 2 ? 1 << 30 : 0, in1 + (size_t)DM_ * INW, INW, DM_, 5120, wsb + WS_WIN + (size_t)INW * DM_ * 2 + WIN_F8_OFF, 1, 0)
    CONV_JOB(128, in6 + (size_t)AW * DM_, DM_, AW, DM_, wsb + WS_WCAT + (size_t)DM_ * DM_ * 2, 0, (4096 << 2))
    CONV_JOB(128, in7 + (size_t)PW * DM_, DM_, PW, DM_, wsb + WS_WBP + (size_t)DM_ * PW * 2, 0, 0)
    CONV_JOB(256, in8 + (size_t)DM_ * DM_, DM_, DM_, DM_, wsb + WS_WOUT + (size_t)DM_ * DM_ * 2, 0, 0)
#undef CONV_JOB
    const int nbn = N / 128, kb = r / nbn, nb = r - kb * nbn;
    (void)K; c.src = src + (size_t)(128 * kb) * ldw + (win ? win_src_col(128 * nb, win - 1) : 128 * nb); c.ldw = ldw; c.f8 = f8; c.sc = W8_SCALE_UP; c.pitch = pitch; c.gath = (win && nb < 8) ? 1 : 0;
    c.dst = dst + (size_t)(mode == 0 ? 128 * nb : 256 * nb + 128 * (mode - 1)) * c.pitch + (f8 ? 128 * kb : 256 * kb);
    return c;
}
constexpr int CW_CONV = 16384 + 64 * 16;
__device__ __forceinline__ void conv_pool(LAS unsigned char* lds, volatile LAS unsigned* MISC, int tid) {
    const int lane = tid & 63, wave = tid >> 6;
    unsigned char* const P_ws = arg_ws(); const float* const P_in1 = arg_in(1); const float* const P_in6 = arg_in(6); const float* const P_in7 = arg_in(7); const float* const P_in8 = arg_in(8); const float* const P_in12 = arg_in(12);
    const float* const P_in13 = arg_in(13); const float* const P_in14 = arg_in(14); const float* const P_in16 = arg_in(16); const float* const P_in17 = arg_in(17); const float* const P_in18 = arg_in(18);
    unsigned* const ctr = (unsigned*)(P_ws + WS_CTL) + CW_CONV;
    f32x4 la[8], lb[8];
#define CONV_CLAIM(slot) do { if (tid == 0) MISC[24 + (slot)] = __hip_atomic_fetch_add(ctr, 1u, __ATOMIC_RELAXED, __HIP_MEMORY_SCOPE_AGENT); } while (0)
#define CONV_LOAD(R, blk) do { if ((blk) < CONV_TOTB) { const ConvBlk cb_ = conv_decode(blk, CONV_PTR_ARGS); _Pragma("unroll") for (int i = 0; i < 8; ++i) { const int row = 16 * wave + 2 * i + (lane >> 5); \
        const int c4_ = 4 * (lane & 31); R[i] = __builtin_nontemporal_load((const f32x4*)(cb_.src + (size_t)row * cb_.ldw + c4_ + (cb_.gath ? (c4_ & 64) : 0))); } } } while (0)
#define CONV_STAGE(R, buf) do { _Pragma("unroll") for (int i = 0; i < 8; ++i) { const int row = 16 * wave + 2 * i + (lane >> 5), col = (4 * (lane & 31) + 16 * (row >> 4)) & 127; \
        *(LAS f32x4*)(lds + (buf) * 65536 + (row * 128 + col) * 4) = R[i]; } } while (0)
#define CONV_OUT(blk, buf) do { const ConvBlk cb_ = conv_decode(blk, CONV_PTR_ARGS); const float sc = cb_.sc; \
        const int c = tid & 7, pr = tid >> 3;                         \
        const LAS attn_body::f32x2_t* q = (const LAS attn_body::f32x2_t*)(lds + (buf) * 65536) + ((16 * c) * 128 + ((2 * pr + 16 * c) & 127)) / 2; \
        attn_body::f32x2_t e[16]; _Pragma("unroll") for (int i = 0; i < 16; ++i) e[i] = q[i * 64]; \
        if (cb_.f8) { v4u o0, o1; \
            o0.x = pg8::pk4_fp8(e[0].x * sc, e[1].x * sc, e[2].x * sc, e[3].x * sc);     o0.y = pg8::pk4_fp8(e[4].x * sc, e[5].x * sc, e[6].x * sc, e[7].x * sc); \
            o0.z = pg8::pk4_fp8(e[8].x * sc, e[9].x * sc, e[10].x * sc, e[11].x * sc);   o0.w = pg8::pk4_fp8(e[12].x * sc, e[13].x * sc, e[14].x * sc, e[15].x * sc); \
            o1.x = pg8::pk4_fp8(e[0].y * sc, e[1].y * sc, e[2].y * sc, e[3].y * sc);     o1.y = pg8::pk4_fp8(e[4].y * sc, e[5].y * sc, e[6].y * sc, e[7].y * sc); \
            o1.z = pg8::pk4_fp8(e[8].y * sc, e[9].y * sc, e[10].y * sc, e[11].y * sc);   o1.w = pg8::pk4_fp8(e[12].y * sc, e[13].y * sc, e[14].y * sc, e[15].y * sc); \
            *(GAS v4u*)(cb_.dst + (size_t)(2 * pr) * cb_.pitch + 16 * c) = o0; *(GAS v4u*)(cb_.dst + (size_t)(2 * pr + 1) * cb_.pitch + 16 * c) = o1; } \
        else { _Pragma("unroll") for (int h = 0; h < 2; ++h) { v4u o0, o1; \
                o0.x = pk2(h ? e[0].y : e[0].x, h ? e[1].y : e[1].x); o0.y = pk2(h ? e[2].y : e[2].x, h ? e[3].y : e[3].x); o0.z = pk2(h ? e[4].y : e[4].x, h ? e[5].y : e[5].x); o0.w = pk2(h ? e[6].y : e[6].x, h ? e[7].y : e[7].x); \
                o1.x = pk2(h ? e[8].y : e[8].x, h ? e[9].y : e[9].x); o1.y = pk2(h ? e[10].y : e[10].x, h ? e[11].y : e[11].x); o1.z = pk2(h ? e[12].y : e[12].x, h ? e[13].y : e[13].x); o1.w = pk2(h ? e[14].y : e[14].x, h ? e[15].y : e[15].x); \
                GAS v4u* d = (GAS v4u*)(cb_.dst + (size_t)(2 * pr + h) * cb_.pitch + 32 * c); d[0] = o0; d[1] = o1; } } } while (0)
    CONV_CLAIM(0); CONV_CLAIM(1); CONV_CLAIM(2);
    __syncthreads();
    int cur = (int)MISC[24], n1 = (int)MISC[25], n2 = (int)MISC[26];
    CONV_LOAD(la, cur); CONV_LOAD(lb, n1);
    if (cur < CONV_TOTB) CONV_STAGE(la, 0);
    __syncthreads();
    CONV_LOAD(la, n2);
    int par = 0;
    while (cur < CONV_TOTB) {
        unsigned cl = 0u; if (tid == 0) cl = __hip_atomic_fetch_add(ctr, 1u, __ATOMIC_RELAXED, __HIP_MEMORY_SCOPE_AGENT);
        CONV_OUT(cur, par);
        if (n1 < CONV_TOTB) CONV_STAGE(lb, par ^ 1);
        if (tid == 0) MISC[24] = cl;
        __syncthreads();
        { const int n3 = (int)MISC[24]; cur = n1; n1 = n2; n2 = n3; par ^= 1; }
        CONV_LOAD(lb, n2);
        if (cur >= CONV_TOTB) break;
        cl = 0u; if (tid == 0) cl = __hip_atomic_fetch_add(ctr, 1u, __ATOMIC_RELAXED, __HIP_MEMORY_SCOPE_AGENT);
        CONV_OUT(cur, par);
        if (n1 < CONV_TOTB) CONV_STAGE(la, par ^ 1);
        if (tid == 0) MISC[25] = cl;
        __syncthreads();
        { const int n3 = (int)MISC[25]; cur = n1; n1 = n2; n2 = n3; par ^= 1; }
        CONV_LOAD(la, n2);
    }
    __syncthreads();
#undef CONV_CLAIM
#undef CONV_LOAD
#undef CONV_STAGE
#undef CONV_OUT
}

__device__ __forceinline__ void ph_prologue(const Args& a, LAS unsigned char* lds, int vcu, int G, int wave, int lane, int tid) {
    unsigned char* ws = arg_ws();
    LAS float* scr = (LAS float*)(lds + RING_OFF + wave * 16384);
    const int gw = vcu * NWAVES + wave, NGW = G * NWAVES;
    for (int jb = -6; jb < 2; jb += 2) {
        const float* src; bf16* dst; int K, N, mode = 0, ldw = 0; bool f8 = false; float sc8 = W8_SCALE_UP;
        int comp = 0;
        if (jb == -4)     { src = arg_in(1); dst = (bf16*)(ws + WS_WIN + WIN_F8_OFF); K = DM_; N = 5120; ldw = INW; f8 = true; comp = 1; }
        else if (jb == 0) { src = arg_in(1); dst = (bf16*)(ws + WS_WIN); K = DM_; N = 3072; ldw = INW; }
        else continue;
        const int nitems = (K / 64) * (N / 32), nblk = N / 32;
        if (!f8) { for (int it = gw; it < nitems; it += NGW) { const int n0 = 32 * (it % nblk); p0_transpose_item(src + (win_src_col(n0, comp) - n0), ldw, K, N, dst, mode, scr, it, lane); } }
        else { for (int it = gw; it < nitems; it += NGW) { const int n0 = 32 * (it % nblk); p0_transpose_item8(src + (win_src_col(n0, comp) - n0), ldw, K, N, (unsigned char*)dst, mode, sc8, scr, it, lane); } }
    }
    {
        const float* x = arg_in(0); bf16* xb = (bf16*)(ws + WS_XB); unsigned char* x8 = (unsigned char*)(ws + WS_X8IN);
        const size_t nchunk = (size_t)TOK * DM_ / 8;
        for (size_t i = (size_t)gw * 64 + lane; i < nchunk; i += (size_t)NGW * 64) {
            const f32x4 a0 = *(const GAS f32x4*)(x + 8 * i), a1 = *(const GAS f32x4*)(x + 8 * i + 4);
            v4u o; o.x = pk2(a0.x, a0.y); o.y = pk2(a0.z, a0.w); o.z = pk2(a1.x, a1.y); o.w = pk2(a1.z, a1.w);
            *(GAS v4u*)(xb + 8 * i) = o;
            u32x2_t o8; o8.x = pg8::pk4_fp8(a0.x * X8_SCALE, a0.y * X8_SCALE, a0.z * X8_SCALE, a0.w * X8_SCALE); o8.y = pg8::pk4_fp8(a1.x * X8_SCALE, a1.y * X8_SCALE, a1.z * X8_SCALE, a1.w * X8_SCALE);
            *(GAS u32x2_t*)(x8 + 8 * i) = o8; }
    }
    {
        const float* pw = arg_in(4); const float* ps = arg_in(5); bf16* pb = (bf16*)(ws + WS_POOLB);
        const int nchunk = 2 * 4 * 256 * 256 / 8;
        for (int i = gw * 64 + lane; i < nchunk; i += NGW * 64) {
            const int f = 8 * i, e0 = f & 255, g = (f >> 16) & 3, l = f >> 18;
            const float* sp = ps + l * PW + 256 * g + e0;
            const f32x4 a0 = *(const GAS f32x4*)(pw + f), a1 = *(const GAS f32x4*)(pw + f + 4), s0 = *(const GAS f32x4*)sp, s1 = *(const GAS f32x4*)(sp + 4);
            v4u o; o.x = pk2(a0.x * s0.x, a0.y * s0.y); o.y = pk2(a0.z * s0.z, a0.w * s0.w); o.z = pk2(a1.x * s1.x, a1.y * s1.y); o.w = pk2(a1.z * s1.z, a1.w * s1.w);
            *(GAS v4u*)(pb + f) = o; }
    }
    if (vcu == 0) {
        float* tab = (float*)(ws + WS_TAB);
        if (wave < 2) {
            const float* lv = arg_in(2) + wave * 256;
            const float p = wave_sum(lv[lane] * lv[64 + lane]), q = wave_sum(lv[128 + lane] * lv[192 + lane]);
            const float lam_init = (wave == 0) ? 0.2f : 0.35550906759096926f;
            if (lane == 0) tab[64 * wave] = expf(p) - expf(q) + lam_init;
        }
        const float* rb = arg_in(9);
        for (int i = tid; i < 1024; i += NWAVES * 64) {
            const int h = i >> 7, n = i & 127; int bk;
            if (n < 16) bk = n; else { bk = 16 + (int)(logf((float)n / 16.0f) / 2.0794415416798357f * 16.0f); bk = bk > 31 ? 31 : bk; }
            tab[1024 + i] = (rb[bk * 8 + h] - rb[31 * 8 + h]) * 1.4426950408889634f;
        }
    }
}

__device__ __forceinline__ void ph_finalize(const Args& a, int L, int vcu, int G, int wave, int lane) {
    unsigned char* ws = arg_ws();
    const int gw = vcu * NWAVES + wave, NGW = G * NWAVES;
    const bf16* O0 = (const bf16*)(ws + WS_O0); const bf16* O1 = (const bf16*)(ws + WS_O1); const bf16* U = (const bf16*)(ws + WS_QKV) + (size_t)3 * TOK * 1024;
    bf16* AZ = (bf16*)(ws + WS_AO);
    const float lam = ld_f32_agent((const float*)(ws + WS_TAB) + 64 * L);
    const float lam_init = (L == 0) ? 0.2f : 0.35550906759096926f;
    const float* sw = arg_in(3) + L * 128 + (16 * lane & 127);
    const int g = lane >> 4, w = 2 << g;
    const int R = (TOK + NGW - 1) / NGW, t0 = gw * R, t1 = (t0 + R < TOK) ? t0 + R : TOK;
    for (int t = t0; t < t1; ++t) {
        {
            const v4u* p0 = (const v4u*)(O0 + (size_t)t * 1024 + 16 * lane); const v4u* p1 = (const v4u*)(O1 + (size_t)t * 1024 + 16 * lane);
            const v4u a0 = p0[0], a1 = p0[1], b0 = p1[0], b1 = p1[1];
            const unsigned aw[8] = {a0.x, a0.y, a0.z, a0.w, a1.x, a1.y, a1.z, a1.w}, bw[8] = {b0.x, b0.y, b0.z, b0.w, b1.x, b1.y, b1.z, b1.w};
            float o[16]; float ss = 0.f;
#pragma unroll
            for (int i = 0; i < 8; ++i) { o[2 * i] = pg8::bflo(aw[i]) - lam * pg8::bflo(bw[i]); o[2 * i + 1] = pg8::bfhi(aw[i]) - lam * pg8::bfhi(bw[i]); ss += o[2 * i] * o[2 * i] + o[2 * i + 1] * o[2 * i + 1]; }
            ss += dppf<0xB1>(ss); ss += dppf<0x4E>(ss); ss += dppf<0x141>(ss);
            const float r = (1.0f - lam_init) / sqrtf(ss * (1.0f / 128.0f) + LN_EPS);
            float swv[16];
#pragma unroll
            for (int i = 0; i < 4; ++i) { const f32x4 w4 = *(const f32x4*)(sw + 4 * i); swv[4 * i] = w4.x; swv[4 * i + 1] = w4.y; swv[4 * i + 2] = w4.z; swv[4 * i + 3] = w4.w; }
            v4u q0, q1;
            q0.x = pk2(o[0] * r * swv[0], o[1] * r * swv[1]); q0.y = pk2(o[2] * r * swv[2], o[3] * r * swv[3]); q0.z = pk2(o[4] * r * swv[4], o[5] * r * swv[5]); q0.w = pk2(o[6] * r * swv[6], o[7] * r * swv[7]);
            q1.x = pk2(o[8] * r * swv[8], o[9] * r * swv[9]); q1.y = pk2(o[10] * r * swv[10], o[11] * r * swv[11]); q1.z = pk2(o[12] * r * swv[12], o[13] * r * swv[13]); q1.w = pk2(o[14] * r * swv[14], o[15] * r * swv[15]);
            v4u* po = (v4u*)(AZ + (size_t)t * 2048 + 16 * lane); po[0] = q0; po[1] = q1;
        }
    }
    {
        float s[16];
#pragma unroll
        for (int i = 0; i < 16; ++i) s[i] = 0.f;
        for (int t = t0; t < t1; ++t) {
            const int pos = t & (SEQ - 1); const int nwin = (pos + 1) < w ? (pos + 1) : w;
            float u0[16];
            if (t == t0 || pos == 0) {
#pragma unroll
                for (int i = 0; i < 16; ++i) s[i] = 0.f;
#pragma unroll
                for (int hb = 0; hb < 4; ++hb) {
                    v4u c0[4], c1[4];
#pragma unroll
                    for (int dd = 0; dd < 4; ++dd) { const int d = 4 * hb + dd; const v4u* p = (const v4u*)(U + (size_t)(t - (d < nwin ? d : 0)) * 1024 + 16 * lane); c0[dd] = p[0]; c1[dd] = p[1]; }
#pragma unroll
                    for (int dd = 0; dd < 4; ++dd) { const int d = 4 * hb + dd; const float mk = d < nwin ? 1.f : 0.f;
                        const unsigned cw[8] = {c0[dd].x, c0[dd].y, c0[dd].z, c0[dd].w, c1[dd].x, c1[dd].y, c1[dd].z, c1[dd].w};
#pragma unroll
                        for (int i = 0; i < 8; ++i) { const float lo = pg8::bflo(cw[i]), hi = pg8::bfhi(cw[i]); s[2 * i] += mk * lo; s[2 * i + 1] += mk * hi; if (d == 0) { u0[2 * i] = lo; u0[2 * i + 1] = hi; } } }
                }
            } else {
                const bool drop = pos >= w; const float mk = drop ? 1.f : 0.f;
                const v4u* pn = (const v4u*)(U + (size_t)t * 1024 + 16 * lane); const v4u* pd = (const v4u*)(U + (size_t)(t - (drop ? w : 0)) * 1024 + 16 * lane);
                const v4u n0 = pn[0], n1 = pn[1], d0 = pd[0], d1 = pd[1];
                const unsigned nw[8] = {n0.x, n0.y, n0.z, n0.w, n1.x, n1.y, n1.z, n1.w}, dw[8] = {d0.x, d0.y, d0.z, d0.w, d1.x, d1.y, d1.z, d1.w};
#pragma unroll
                for (int i = 0; i < 8; ++i) { u0[2 * i] = pg8::bflo(nw[i]); u0[2 * i + 1] = pg8::bfhi(nw[i]);
                    s[2 * i] += u0[2 * i] - mk * pg8::bflo(dw[i]); s[2 * i + 1] += u0[2 * i + 1] - mk * pg8::bfhi(dw[i]); }
            }
            const float inv = 1.0f / (float)nwin;
            v4u q0, q1;
            q0.x = pk2(s[0] * inv - u0[0], s[1] * inv - u0[1]); q0.y = pk2(s[2] * inv - u0[2], s[3] * inv - u0[3]); q0.z = pk2(s[4] * inv - u0[4], s[5] * inv - u0[5]); q0.w = pk2(s[6] * inv - u0[6], s[7] * inv - u0[7]);
            q1.x = pk2(s[8] * inv - u0[8], s[9] * inv - u0[9]); q1.y = pk2(s[10] * inv - u0[10], s[11] * inv - u0[11]); q1.z = pk2(s[12] * inv - u0[12], s[13] * inv - u0[13]); q1.w = pk2(s[14] * inv - u0[14], s[15] * inv - u0[15]);
            v4u* po = (v4u*)(AZ + (size_t)t * 2048 + 1024 + 16 * lane); po[0] = q0; po[1] = q1;
        }
    }
}

#define LN_COL(j) (512 * ((j) >> 1) + 4 * ((j) & 1))
__device__ __forceinline__ void ln_load_raw(v4u (&w)[4], const bf16* row, int lane) {
    const GAS v4u* p = (const GAS v4u*)(row + 8 * lane);
#pragma unroll
    for (int jj = 0; jj < 4; ++jj) w[jj] = p[64 * jj];
}
__device__ __forceinline__ void ln_cvt_raw(f32x4 (&v)[8], const v4u (&w)[4]) {
#pragma unroll
    for (int jj = 0; jj < 4; ++jj) { v[2 * jj] = (f32x4){pg8::bflo(w[jj].x), pg8::bfhi(w[jj].x), pg8::bflo(w[jj].y), pg8::bfhi(w[jj].y)}; v[2 * jj + 1] = (f32x4){pg8::bflo(w[jj].z), pg8::bfhi(w[jj].z), pg8::bflo(w[jj].w), pg8::bfhi(w[jj].w)}; }
}
__device__ __forceinline__ void ln_load_bf16(f32x4 (&v)[8], const bf16* row, int lane) {
    const GAS v4u* p = (const GAS v4u*)(row + 8 * lane);
#pragma unroll
    for (int jj = 0; jj < 4; ++jj) { const v4u w = p[64 * jj]; v[2 * jj] = (f32x4){pg8::bflo(w.x), pg8::bfhi(w.x), pg8::bflo(w.y), pg8::bfhi(w.y)}; v[2 * jj + 1] = (f32x4){pg8::bflo(w.z), pg8::bfhi(w.z), pg8::bflo(w.w), pg8::bfhi(w.w)}; }
}
__device__ __forceinline__ void ln_store_bf16(const f32x4 (&v)[8], bf16* row, int lane) {
    GAS v4u* p = (GAS v4u*)(row + 8 * lane);
#pragma unroll
    for (int jj = 0; jj < 4; ++jj) { v4u w; w.x = pk2(v[2 * jj].x, v[2 * jj].y); w.y = pk2(v[2 * jj].z, v[2 * jj].w); w.z = pk2(v[2 * jj + 1].x, v[2 * jj + 1].y); w.w = pk2(v[2 * jj + 1].z, v[2 * jj + 1].w); p[64 * jj] = w; }
}
__device__ __forceinline__ void ln_store_fp8(const f32x4 (&v)[8], unsigned char* row, int lane) {
    GAS u32x2_t* p = (GAS u32x2_t*)(row + 8 * lane);
#pragma unroll
    for (int jj = 0; jj < 4; ++jj) { u32x2_t w; w.x = pg8::pk4_fp8(v[2 * jj].x * X8_SCALE, v[2 * jj].y * X8_SCALE, v[2 * jj].z * X8_SCALE, v[2 * jj].w * X8_SCALE);
        w.y = pg8::pk4_fp8(v[2 * jj + 1].x * X8_SCALE, v[2 * jj + 1].y * X8_SCALE, v[2 * jj + 1].z * X8_SCALE, v[2 * jj + 1].w * X8_SCALE); p[64 * jj] = w; }
}
__device__ __forceinline__ void ln_core(f32x4 (&v)[8], const float* gp, const float* bp, int lane) {
    float s = 0.f;
#pragma unroll
    for (int j = 0; j < 8; ++j) s += (v[j].x + v[j].y) + (v[j].z + v[j].w);
    const float mean = wave_sum(s) * (1.f / DM_); float s2 = 0.f;
#pragma unroll
    for (int j = 0; j < 8; ++j) { v[j] = v[j] - mean; s2 += (v[j].x * v[j].x + v[j].y * v[j].y) + (v[j].z * v[j].z + v[j].w * v[j].w); }
    const float rstd = 1.f / sqrtf(wave_sum(s2) * (1.f / DM_) + LN_EPS);
    int lo8 = 8 * lane; asm volatile("" : "+v"(lo8)); const float* gl = gp + lo8; const float* bl = bp + lo8;
#pragma unroll
    for (int j = 0; j < 8; ++j) { const f32x4 gg = *(const f32x4*)(gl + LN_COL(j)), bb = *(const f32x4*)(bl + LN_COL(j)); v[j] = v[j] * rstd * gg + bb; }
}
__device__ __forceinline__ void ln_core2(f32x4 (&va)[8], f32x4 (&vb)[8], const float* gp, const float* bp, int lane, float* sta, float* stb) {
    float sa = 0.f, sb = 0.f;
#pragma unroll
    for (int j = 0; j < 8; ++j) { sa += (va[j].x + va[j].y) + (va[j].z + va[j].w); sb += (vb[j].x + vb[j].y) + (vb[j].z + vb[j].w); }
    const float ma = wave_sum(sa) * (1.f / DM_), mb = wave_sum(sb) * (1.f / DM_); float qa = 0.f, qb = 0.f;
#pragma unroll
    for (int j = 0; j < 8; ++j) { va[j] = va[j] - ma; vb[j] = vb[j] - mb; qa += (va[j].x * va[j].x + va[j].y * va[j].y) + (va[j].z * va[j].z + va[j].w * va[j].w); qb += (vb[j].x * vb[j].x + vb[j].y * vb[j].y) + (vb[j].z * vb[j].z + vb[j].w * vb[j].w); }
    const float ra = 1.f / sqrtf(wave_sum(qa) * (1.f / DM_) + LN_EPS), rb = 1.f / sqrtf(wave_sum(qb) * (1.f / DM_) + LN_EPS);
    int lo8 = 8 * lane; asm volatile("" : "+v"(lo8)); const float* gl = gp + lo8; const float* bl = bp + lo8;
#pragma unroll
    for (int j = 0; j < 8; ++j) { const f32x4 gg = *(const f32x4*)(gl + LN_COL(j)), bb = *(const f32x4*)(bl + LN_COL(j)); va[j] = va[j] * ra * gg + bb; vb[j] = vb[j] * rb * gg + bb; }
    if (lane == 0) { sta[0] = ma; sta[1] = ra; stb[0] = mb; stb[1] = rb; }
}
#ifndef LOCAL_LN
#define LOCAL_LN 0
#endif
#ifndef LOCAL_RT
#define LOCAL_RT 0
#endif
__device__ __forceinline__ int ln_row(int vcu, int wave, int G, int j, bool local = true) {
    const int NGW = G * NWAVES;
    if (local && G % 8 == 0 && (TOK / 8) % (NGW / 8) == 0) { const int gpx = G / 8, x = vcu / gpx, lw = (vcu - x * gpx) * NWAVES + wave; return x * (TOK / 8) + lw + (NGW / 8) * j; }
    return vcu * NWAVES + wave + NGW * j;
}
template <int MODE>
__device__ __forceinline__ void ph_ln(const bf16* src, const bf16* y2, const float* gp, const float* bp, float* st, const float* g1, const float* b1, float* dst, bf16* dstb, unsigned char* dst8, int vcu, int G, int wave, int lane) {
    const int gw = vcu * NWAVES + wave, NGW = G * NWAVES;
    static_assert(TOK % 2 == 0, "rows are taken in pairs");
    if (MODE == 2) {
        for (int m = gw; m < TOK; m += NGW) {
            f32x4 v[8], a[8], b[8];
            ln_load_bf16(v, src + (size_t)m * DM_, lane); ln_load_bf16(a, y2 + (size_t)(2 * m) * DM_, lane); ln_load_bf16(b, y2 + (size_t)(2 * m + 1) * DM_, lane);
            const float mu = st[2 * m], rs = st[2 * m + 1];
            int lo8 = 8 * lane; asm volatile("" : "+v"(lo8));
            const float* g1l = g1 + lo8; const float* b1l = b1 + lo8;
#pragma unroll
            for (int j = 0; j < 8; ++j) { const f32x4 gg = *(const f32x4*)(g1l + LN_COL(j)), bb = *(const f32x4*)(b1l + LN_COL(j)); v[j] = ((v[j] - mu) * rs * gg + bb) * ALPHA + (a[j] + b[j]); }
            ln_core(v, gp, bp, lane);
            GAS f32x4* o = (GAS f32x4*)(dst + (size_t)m * DM_ + 8 * lane);
#pragma unroll
            for (int j = 0; j < 8; ++j) o[LN_COL(j) / 4] = v[j];
        }
        return;
    }
    static_assert(TOK % (256 * NWAVES) == 0, "rows per wave");
    const int RPW = TOK / NGW;
    for (int jp = 0; jp < RPW / 2; ++jp) {
        const int mr[2] = {ln_row(vcu, wave, G, jp, LOCAL_LN), ln_row(vcu, wave, G, jp + RPW / 2, LOCAL_LN)};
        f32x4 v[2][8];
#pragma unroll
        for (int q = 0; q < 2; ++q) ln_load_bf16(v[q], src + (size_t)mr[q] * DM_, lane);
        ln_core2(v[0], v[1], gp, bp, lane, st + 2 * mr[0], st + 2 * mr[1]);
#pragma unroll
        for (int q = 0; q < 2; ++q) { const int m = mr[q];
            if (dstb) ln_store_bf16(v[q], dstb + (size_t)m * DM_, lane);
            if (dst8) ln_store_fp8(v[q], dst8 + (size_t)m * DM_, lane); }
    }
}
__device__ __forceinline__ void ph_ln_router(const Args& a, const bf16* src, const float* gp, const float* bp, float* st, bf16* dstb, LAS unsigned char* lds, volatile LAS unsigned* MISC, int vcu, int G, int wave, int lane, int tid) {
    unsigned char* ws = arg_ws();
    const int gw = vcu * NWAVES + wave, NGW = G * NWAVES;
    LAS float* rwT = (LAS float*)(lds + RING_OFF);
    const float* rw = arg_in(15);
    for (int i = tid; i < DM_ * NEXP; i += NWAVES * 64) rwT[(i & 7) * DM_ + (i >> 3)] = rw[i];
    if (tid < 8) MISC[16 + tid] = 0u;
    __syncthreads();
    int* tokinfo = (int*)(ws + WS_TOKINFO);
    v4u nraw[2][4];
    const int RPW = TOK / NGW;
    {
#pragma unroll
        for (int q = 0; q < 2; ++q) ln_load_raw(nraw[q], src + (size_t)ln_row(vcu, wave, G, q, LOCAL_RT) * DM_, lane); }
    for (int jp = 0; jp < RPW; jp += 2) {
        const int mr[2] = {ln_row(vcu, wave, G, jp, LOCAL_RT), ln_row(vcu, wave, G, jp + 1, LOCAL_RT)};
        f32x4 v[2][8];
#pragma unroll
        for (int q = 0; q < 2; ++q) ln_cvt_raw(v[q], nraw[q]);
        if (jp + 2 < RPW) {
#pragma unroll
            for (int q = 0; q < 2; ++q) ln_load_raw(nraw[q], src + (size_t)ln_row(vcu, wave, G, jp + 2 + q, LOCAL_RT) * DM_, lane); }
        ln_core2(v[0], v[1], gp, bp, lane, st + 2 * mr[0], st + 2 * mr[1]);
        float lg[2][8];
#pragma unroll
        for (int q = 0; q < 2; ++q) ln_store_fp8(v[q], (unsigned char*)dstb + (size_t)mr[q] * DM_, lane);
#pragma unroll
        for (int e = 0; e < 8; ++e) { float p0 = 0.f, p1 = 0.f;
#pragma unroll
            for (int j = 0; j < 8; ++j) { const f32x4 r4 = *(const LAS f32x4*)(rwT + e * DM_ + 8 * lane + LN_COL(j));
                p0 += (v[0][j].x * r4.x + v[0][j].y * r4.y) + (v[0][j].z * r4.z + v[0][j].w * r4.w); p1 += (v[1][j].x * r4.x + v[1][j].y * r4.y) + (v[1][j].z * r4.z + v[1][j].w * r4.w); }
            lg[0][e] = wave_sum(p0); lg[1][e] = wave_sum(p1); }
#pragma unroll
        for (int q = 0; q < 2; ++q) { const int m = mr[q];
            int e0 = 0; float v0 = lg[q][0];
#pragma unroll
            for (int e = 1; e < 8; ++e) if (lg[q][e] > v0) { v0 = lg[q][e]; e0 = e; }
            int e1 = -1; float v1 = -INFINITY;
#pragma unroll
            for (int e = 0; e < 8; ++e) if (e != e0 && lg[q][e] > v1) { v1 = lg[q][e]; e1 = e; }
            const float w0 = 1.0f / (1.0f + expf(v1 - v0)), w1 = 1.0f - w0;
            if (lane == 0) {
                const unsigned p0 = __hip_atomic_fetch_add((LAS unsigned*)(MISC + 16 + e0), 1u, __ATOMIC_RELAXED, __HIP_MEMORY_SCOPE_WORKGROUP), p1 = __hip_atomic_fetch_add((LAS unsigned*)(MISC + 16 + e1), 1u, __ATOMIC_RELAXED, __HIP_MEMORY_SCOPE_WORKGROUP);
                int4 r0 = make_int4(e0, (int)p0, e1, (int)p1), r1 = make_int4((int)__float_as_uint(w0), (int)__float_as_uint(w1), 0, 0);
                *(int4*)(tokinfo + (size_t)m * 8) = r0; *(int4*)(tokinfo + (size_t)m * 8 + 4) = r1;
            } }
    }
    __syncthreads();
    if (tid < 8) {
        const unsigned n = MISC[16 + tid];
        const unsigned base = __hip_atomic_fetch_add((unsigned*)(ws + WS_CTL) + CW_CNT + 64 * tid, n, __ATOMIC_RELAXED, __HIP_MEMORY_SCOPE_AGENT);
        ((unsigned*)(ws + WS_BBASE))[vcu * 8 + tid] = base;
    }
    __syncthreads();
}
__device__ __forceinline__ void load_cnt(const unsigned char* ws, unsigned (&cnt)[8]) {
#pragma unroll
    for (int e = 0; e < 8; ++e) cnt[e] = (unsigned)__builtin_amdgcn_readfirstlane((int)ld_u32_agent((const unsigned*)(ws + WS_CTL) + CW_CNT + 64 * e));
}
__device__ __forceinline__ void ph_gather(const Args& a, int vcu, int G, int wave, int lane) {
    unsigned char* ws = arg_ws();
    const int gw = vcu * NWAVES + wave, NGW = G * NWAVES;
    unsigned cnt[8]; load_cnt(ws, cnt);
    int off[8]; { int o = 0;
#pragma unroll
        for (int e = 0; e < 8; ++e) { off[e] = o; o += (int)((cnt[e] + 255u) & ~255u); } }
    const int* tokinfo = (const int*)(ws + WS_TOKINFO); const unsigned* bbase = (const unsigned*)(ws + WS_BBASE);
    int* rowmap = (int*)(ws + WS_ROWMAP); float* roww = (float*)(ws + WS_ROWW);
    const unsigned char* Hb = (const unsigned char*)(ws + WS_XB); unsigned char* Xs = (unsigned char*)(ws + WS_XS);
    int bb[8];
#pragma unroll
    for (int e = 0; e < 8; ++e) bb[e] = off[e] + (int)bbase[vcu * 8 + e];
    constexpr int GB = 4;
    for (int jb = 0; jb < TOK / NGW; jb += GB) {
        int4 r0[GB], r1[GB]; v4u x0[GB], x1[GB];
#pragma unroll
        for (int q = 0; q < GB; ++q) { const int t = (jb + q < TOK / NGW) ? ln_row(vcu, wave, G, jb + q, LOCAL_RT) : TOK; if (t < TOK) {
            r0[q] = *(const int4*)(tokinfo + (size_t)t * 8); r1[q] = *(const int4*)(tokinfo + (size_t)t * 8 + 4);
            const GAS v4u* sp = (const GAS v4u*)(Hb + (size_t)t * DM_) + lane; x0[q] = sp[0]; x1[q] = sp[64]; } }
#pragma unroll
        for (int q = 0; q < GB; ++q) { const int t = (jb + q < TOK / NGW) ? ln_row(vcu, wave, G, jb + q, LOCAL_RT) : TOK; if (t < TOK) {
            const int e0 = r0[q].x, e1 = r0[q].z; int o0 = 0, o1 = 0;
#pragma unroll
            for (int e = 0; e < 8; ++e) { if (e == e0) o0 = bb[e]; if (e == e1) o1 = bb[e]; }
            const int row0 = o0 + r0[q].y, row1 = o1 + r0[q].w;
            GAS v4u* d0 = (GAS v4u*)(Xs + (size_t)row0 * DM_) + lane; GAS v4u* d1 = (GAS v4u*)(Xs + (size_t)row1 * DM_) + lane;
            d0[0] = x0[q]; d0[64] = x1[q]; d1[0] = x0[q]; d1[64] = x1[q];
            if (lane == 0) { rowmap[row0] = 2 * t; roww[row0] = __int_as_float(r1[q].x); rowmap[row1] = 2 * t + 1; roww[row1] = __int_as_float(r1[q].y); } } }
    }
#pragma unroll
    for (int e = 0; e < 8; ++e) {
        const int pend = (int)((cnt[e] + 255u) & ~255u);
        for (int r = (int)cnt[e] + gw; r < pend; r += NGW) {
            const int row = off[e] + r;
            GAS v4u* d = (GAS v4u*)(Xs + (size_t)row * DM_) + lane;
#pragma unroll
            for (int j = 0; j < 2; ++j) d[64 * j] = (v4u){0u, 0u, 0u, 0u};
            if (lane == 0) { rowmap[row] = -1; roww[row] = 0.f; }
        }
    }
}


#ifndef PH_MASK
#define PH_MASK 0xffffffffu
#endif
#define IN(k) (((PH_MASK >> (k)) & 1u) != 0u && lo <= (k) && (k) < hi)
#define SEAM(k) do { if (lo <= (k) && (k) + 1 < hi) xcd_barrier(bar); } while (0)
#ifndef PROBE_REP
#define PROBE_REP -1
#endif
#define ws arg_ws()
#define WIN ((bf16*)(ws + WS_WIN))
#define WCAT ((bf16*)(ws + WS_WCAT))
#define WBP ((bf16*)(ws + WS_WBP))
#define WOUT ((bf16*)(ws + WS_WOUT))
#define POOLB ((bf16*)(ws + WS_POOLB))
#define QKV ((bf16*)(ws + WS_QKV))
#define XB ((bf16*)(ws + WS_XB))
#define STATS(i) ((float*)(ws + WS_STATS) + (size_t)(i) * 2 * TOK)
#define YF ((bf16*)(ws + WS_Y))
#define MG ((bf16*)(ws + WS_MG))
#define MERGED ((bf16*)(ws + WS_MERGED))
#define AO ((bf16*)(ws + WS_AO))
#define ZB ((bf16*)(ws + WS_ZB))
#define PH_IDS int tid_ = threadIdx.x; asm volatile("" : "+v"(tid_)); const int tid = tid_, lane = tid & 63, wave = __builtin_amdgcn_readfirstlane(tid >> 6); (void)tid; (void)lane; (void)wave
template <int L>
__device__ __forceinline__ void layer_phases(const Args& args, LAS unsigned char* lds, unsigned char* lds_raw, volatile LAS unsigned* MISC, const XcdBarrier& bar, int lo, int hi, int vcu, int G) {
    {

        constexpr int pb = 2 + 10 * L;
        if (IN(pb + 0)) { PH_IDS;
            { pg8::Gemm g{XB, WIN + (size_t)L * INW * DM_, DM_, DM_, DM_}; pg8::StaticOrder S; S.init(TOK, 3072, G, (int)blockIdx.x);
              pg8::EpiInProj E{QKV, attn_body::C2, 0, 2, 1.0f};
              pg8::gemm_phase<pg8::EpiInProj, pg8::StaticOrder, true>(lds + RING_OFF, g, S, E); }
            { pg8::Gemm g{(const bf16*)(ws + WS_X8IN), (const bf16*)(ws + WS_WIN + (size_t)L * INW * DM_ * 2 + WIN_F8_OFF), DM_ / 2, DM_ / 2, DM_ / 2}; pg8::StaticOrder S; S.init(TOK, 5120, G, (int)blockIdx.x);
              pg8::EpiInProj E{QKV, attn_body::C2, 1, 4, 1.0f / (X8_SCALE * W8_SCALE_UP)};
              pg8::gemm_phase<pg8::EpiInProj, pg8::StaticOrder, true, true>(lds + RING_OFF, g, S, E); }
        }
        SEAM(pb + 0);
        if (IN(pb + 1)) { PH_IDS;
            LAS float* tbl = (LAS float*)(lds + ATT_TBL_OFF);
            const float* tab = (const float*)(ws + WS_TAB) + 1024;
            for (int i = tid; i < 1024; i += NWAVES * 64) tbl[i] = ld_f32_agent(tab + i);
            __syncthreads();
            const attn_body::AttnTensors AT{(const attn_body::bf16*)QKV, (const attn_body::bf16*)(QKV + (size_t)TOK * 1024), (const attn_body::bf16*)(QKV + (size_t)2 * TOK * 1024),
                                            (attn_body::bf16*)(ws + WS_O0), (attn_body::bf16*)(ws + WS_O1)};
            constexpr int A8 = (L == 0) ? ATT_CU_PER_XCD_L0 : 32;
            if ((vcu & 31) < A8) attn_body::attn_phase<8>((char*)lds_raw + RING_OFF, AT, vcu >> 5, vcu & 31, A8, (attn_body::lds_fptr)tbl);
            if constexpr (L == 0) conv_pool(lds, MISC, tid);
        }
        SEAM(pb + 1);
        if (IN(pb + 2)) { PH_IDS;
            if constexpr (L == 0) {
                pg8::Gemm g{WBP, POOLB, 1024, 256, 256}; pg8::FoldOrder S{(int)blockIdx.x}; pg8::EpiBf16Plain E{WCAT + 1024, 2048};
                pg8::gemm_phase<pg8::EpiBf16Plain, pg8::FoldOrder, false>(lds + RING_OFF, g, S, E); }
            ph_finalize(args, L, vcu, G, wave, lane); }
        SEAM(pb + 2);
        if (IN(pb + 3)) { PH_IDS;
            const bf16* GA = QKV + (size_t)4 * TOK * 1024; const bf16* GP = QKV + (size_t)6 * TOK * 1024;
            pg8::Gemm g{AO, WCAT + (size_t)L * DM_ * DM_, DM_, DM_, DM_}; pg8::StaticOrder S; S.init(TOK, DM_, G, (int)blockIdx.x);
            pg8::EpiGateFinal E{GP, MERGED}; pg8::HookGateRatio H{GA, GP};
            pg8::gemm_phase<pg8::EpiGateFinal, pg8::StaticOrder, true, false, pg8::HookGateRatio>(lds + RING_OFF, g, S, E, H);
        }
        SEAM(pb + 3);
        if (IN(pb + 4)) { PH_IDS;
            pg8::Gemm g{MERGED, WOUT + (size_t)L * DM_ * DM_, DM_, DM_, DM_}; pg8::StaticOrder S; S.init(TOK, DM_, G, (int)blockIdx.x);
            if constexpr (L == 0) { pg8::EpiRes E{XB, YF, ALPHA};
              pg8::gemm_phase<pg8::EpiRes, pg8::StaticOrder, true>(lds + RING_OFF, g, S, E); }
            else { pg8::EpiResLn E{YF, STATS(1), arg_in(19), arg_in(20), ALPHA, 1.0f};
              pg8::gemm_phase<pg8::EpiResLn, pg8::StaticOrder, true>(lds + RING_OFF, g, S, E); }
        }
        SEAM(pb + 4);
        if constexpr (L == 0) {
            if (IN(pb + 5)) { PH_IDS; ph_ln<0>(YF, nullptr, arg_in(10), arg_in(11), STATS(0), nullptr, nullptr, nullptr, nullptr, (unsigned char*)XB, vcu, G, wave, lane);   }
            SEAM(pb + 5);
            if (IN(pb + 6)) { PH_IDS;
                pg8::Gemm g{XB, (const bf16*)(ws + WS_WGU_D), DM_ / 2, DM_ / 2, DM_ / 2}; pg8::StaticOrder S; S.init(TOK, 2 * FFD, G, (int)blockIdx.x);
                pg8::EpiSwiglu8<false> E{(unsigned char*)(ws + WS_ACT_D), FFD, 1.0f / (X8_SCALE * W8_SCALE_UP)};
                pg8::gemm_phase<pg8::EpiSwiglu8<false>, pg8::StaticOrder, true, true>(lds + RING_OFF, g, S, E);
            }
            SEAM(pb + 6);
            if (IN(pb + 7)) { PH_IDS;
                pg8::Gemm g{(const bf16*)(ws + WS_ACT_D), (const bf16*)(ws + WS_WD_D), FFD / 2, FFD / 2, FFD / 2}; pg8::StaticOrder S; S.init(TOK, DM_, G, (int)blockIdx.x);
                pg8::EpiResLn E{YF, STATS(0), arg_in(10), arg_in(11), ALPHA, 1.0f / (pg8::ACT8_SCALE * W8_SCALE_UP)};
                pg8::gemm_phase<pg8::EpiResLn, pg8::StaticOrder, true, true>(lds + RING_OFF, g, S, E);
            }
            SEAM(pb + 7);
            if (IN(pb + 8)) { PH_IDS; ph_ln<0>(YF, nullptr, arg_in(19), arg_in(20), STATS(1), nullptr, nullptr, nullptr, XB, (unsigned char*)(ws + WS_X8IN), vcu, G, wave, lane); }
            SEAM(pb + 8);
        } else {
            if (IN(pb + 5)) { PH_IDS; ph_ln_router(args, YF, arg_in(10) + DM_, arg_in(11) + DM_, STATS(2), XB, lds, MISC, vcu, G, wave, lane, tid); }
            SEAM(pb + 5);
            if (IN(pb + 6)) { PH_IDS; ph_gather(args, vcu, G, wave, lane); }
            SEAM(pb + 6);
            if (IN(pb + 7)) { PH_IDS;
                unsigned cnt[8]; load_cnt(ws, cnt);
                { pg8::MoeOrder S; S.init(cnt, 56, G, (int)blockIdx.x);
                  pg8::Gemm g{(const bf16*)(ws + WS_XS), (const bf16*)(ws + WS_WGU_E), DM_ / 2, DM_ / 2, DM_ / 2};
                  pg8::EpiSwiglu8<false> E{(unsigned char*)(ws + WS_ACT_E), FFE, 1.0f / (X8_SCALE * W8_SCALE_UP)};
                  pg8::gemm_phase<pg8::EpiSwiglu8<false>, pg8::MoeOrder, true, true>(lds + RING_OFF, g, S, E); }
            }
            SEAM(pb + 7);
            if (IN(pb + 8)) { PH_IDS;
                unsigned cnt[8]; load_cnt(ws, cnt);
                { pg8::MoeOrder S; S.init(cnt, 8, G, (int)blockIdx.x);
                  pg8::Gemm g{(const bf16*)(ws + WS_ACT_E), (const bf16*)(ws + WS_WD_E), FFE / 2, FFE / 2, FFE / 2};
                  pg8::EpiMoeDown E{(const int*)(ws + WS_ROWMAP), (const float*)(ws + WS_ROWW), (bf16*)(ws + WS_Y2), 1.0f / (pg8::ACT8_SCALE * W8_SCALE_DOWN)};
                  pg8::gemm_phase<pg8::EpiMoeDown, pg8::MoeOrder, true, true>(lds + RING_OFF, g, S, E); }
            }
            SEAM(pb + 8);
            if (IN(pb + 9)) { PH_IDS; ph_ln<2>(YF, (const bf16*)(ws + WS_Y2), arg_in(19) + DM_, arg_in(20) + DM_, STATS(2), arg_in(10) + DM_, arg_in(11) + DM_, arg_out(), nullptr, nullptr, vcu, G, wave, lane); }
        }

    }
}
__global__ void __launch_bounds__(NWAVES * 64, 2) fwd_kernel(Args args) {
    extern __shared__ __attribute__((aligned(16))) unsigned char lds_raw[];
    LAS unsigned char* lds = (LAS unsigned char*)lds_raw;
    volatile LAS unsigned* MISC = (volatile LAS unsigned*)(lds + MISC_OFF);
    const int G = gridDim.x; const int bx = blockIdx.x; const int vcu = (G % 8 == 0) ? (bx % 8) * (G / 8) + bx / 8 : bx;
    gu32* ctl = (gu32*)(arg_ws() + WS_CTL);
    for (int u = threadIdx.x; u < (LDS_BYTES - LDSCTL_OFF) / 4; u += NWAVES * 64) ((LAS unsigned*)(lds + LDSCTL_OFF))[u] = 0u;
    __syncthreads();
    XcdBarrier bar; bar.bar = (unsigned*)(ctl + CW_BAR); bar.x = 0; bar.st = nullptr;
    if (N_LAUNCHES == 1) bar = xcd_barrier_post((unsigned*)(ctl + CW_BAR), MISC + 8);
    const int lo = args.ph_lo, hi = args.ph_hi;


    if (IN(0)) { PH_IDS; ph_prologue(args, lds, vcu, G, wave, lane, tid); }
    SEAM(0);

    layer_phases<0>(args, lds, lds_raw, MISC, bar, lo, hi, vcu, G);
    layer_phases<1>(args, lds, lds_raw, MISC, bar, lo, hi, vcu, G);
#undef IN
#undef SEAM
}
#undef ws
#undef WIN
#undef WCAT
#undef WBP
#undef WOUT
#undef POOLB
#undef QKV
#undef XB
#undef STATS
#undef YF
#undef MG
#undef MERGED
#undef AO
#undef ZB

extern "C" void kernel_launch(void* const* d_in, const int* in_sizes, int n_in, void* d_out, int out_size, void* d_ws, size_t ws_size, hipStream_t stream) {
    static int grid = 0;
    if (grid == 0) {
        if (n_in != 21 || in_sizes[0] != TOK * DM_ || out_size != TOK * DM_ || ws_size < WS_END) { fprintf(stderr, "kernel_launch: unexpected shapes / workspace (n_in %d, ws %zu < %zu); nothing launched\n", n_in, ws_size, (size_t)WS_END); grid = -1; return; }
        int dev = 0, cus = 0, per_cu = 0;
        if (hipGetDevice(&dev) != hipSuccess || hipDeviceGetAttribute(&cus, hipDeviceAttributeMultiprocessorCount, dev) != hipSuccess) { grid = -1; return; }
        if (hipFuncSetAttribute((const void*)fwd_kernel, hipFuncAttributeMaxDynamicSharedMemorySize, LDS_BYTES) != hipSuccess) { fprintf(stderr, "kernel_launch: hipFuncSetAttribute failed\n"); grid = -1; return; }
        if (hipOccupancyMaxActiveBlocksPerMultiprocessor(&per_cu, (const void*)fwd_kernel, NWAVES * 64, LDS_BYTES) != hipSuccess || per_cu < 1)
            fprintf(stderr, "kernel_launch: note: occupancy query reports %d workgroups per CU\n", per_cu);
        (void)hipGetLastError();
        grid = cus;
    }
    if (grid < 0) return;
    if (hipMemsetAsync((char*)d_ws + WS_CTL, 0, CTL_ZERO_BYTES, stream) != hipSuccess) return;
    Args a{};
    for (int i = 0; i < 21; ++i) a.in[i] = (const float*)d_in[i];
    a.out = (float*)d_out; a.ws = (unsigned char*)d_ws;
    for (int li = 0; li < N_LAUNCHES; ++li) {
        a.ph_lo = (N_LAUNCHES == 1) ? 0 : li; a.ph_hi = (N_LAUNCHES == 1) ? NPHASE : li + 1;
        hipLaunchKernelGGL(fwd_kernel, dim3(grid), dim3(NWAVES * 64), LDS_BYTES, stream, a);
        const hipError_t le = hipPeekAtLastError();
        if (le != hipSuccess) { fprintf(stderr, "kernel_launch: launch %d failed: %s\n", li, hipGetErrorName(le)); break; }
    }
}
```
